# Optimizing an MI355X kernel written in HIP

```python
import math
import jax, jax.numpy as jnp
from jax import lax
import numpy as np

D_MODEL = 1024
BATCH = 8
SEQ = 2048
DEPTH = 4
DEC_BATCH = 128
DEC_SEQ = 4
PAST_LEN = 16384
PAGE_SIZE = 128

N_MIXERS = 2
N_CHUNK_LAYERS = (DEPTH + 1) // 2
N_SSM_LAYERS = DEPTH // 2
CHUNK = 128
EXP_A = 2 * D_MODEL
N_GROUPS_A = 8
GROUP_DIM_A = EXP_A // N_GROUPS_A
EXP_B = D_MODEL
SSM_GROUP = 16
N_GROUPS_B = EXP_B // SSM_GROUP
STATE_P = 64
DT_MIN = 1e-3
DT_MAX = 1e-1
EPS = 1e-6

kernel_name = "hybrid_chunk_gmlp_s5_decode_step"


def rmsnorm(x, g):
    xf = x.astype(jnp.float32)
    y = xf * lax.rsqrt(jnp.mean(xf * xf, axis=-1, keepdims=True) + EPS)
    return (y * g.astype(jnp.float32)).astype(x.dtype)


def layernorm(x, g, b):
    xf = x.astype(jnp.float32)
    mu = jnp.mean(xf, axis=-1, keepdims=True)
    xc = xf - mu
    y = xc * lax.rsqrt(jnp.mean(xc * xc, axis=-1, keepdims=True) + EPS)
    return (y * g.astype(jnp.float32) + b.astype(jnp.float32)).astype(x.dtype)


def chunk_gmlp(h, w_in, ln_g, ln_b, w_s, b_s, w_out):
    bn, seq_len, _ = h.shape
    u, v, z = jnp.split(h @ w_in, 3, axis=-1)
    v = layernorm(v, ln_g, ln_b)
    c = min(seq_len, CHUNK)
    n_chunks = seq_len // c
    mask = jnp.tril(jnp.ones((c, c), dtype=bool))
    ws = jnp.where(mask, w_s[:, :c, :c], 0)
    vc = v.reshape(bn, n_chunks, c, N_GROUPS_A, GROUP_DIM_A)
    s = jnp.einsum('hts,bnshd->bnthd', ws, vc) + jnp.transpose(b_s[:, :c])[None, None, :, :, None]
    gated = u * s.reshape(bn, seq_len, EXP_A) * jax.nn.silu(z)
    return gated @ w_out, v


def zoh(a_re, a_im, log_dt, b_re, b_im):
    dt = jnp.exp(log_dt.astype(jnp.float32))[:, None]
    ar = a_re.astype(jnp.float32)
    ai = a_im.astype(jnp.float32)
    mag = jnp.exp(dt * ar)
    ang = dt * ai
    abar_re = mag * jnp.cos(ang)
    abar_im = mag * jnp.sin(ang)
    nr = abar_re - 1.0
    ni = abar_im
    den = ar * ar + ai * ai
    coef_re = (nr * ar + ni * ai) / den
    coef_im = (ni * ar - nr * ai) / den
    br = b_re.astype(jnp.float32)
    bi = b_im.astype(jnp.float32)
    bbar_re = coef_re[..., None] * br - coef_im[..., None] * bi
    bbar_im = coef_re[..., None] * bi + coef_im[..., None] * br
    return abar_re, abar_im, bbar_re, bbar_im


def _combine(e1, e2):
    a1r, a1i, b1r, b1i = e1
    a2r, a2i, b2r, b2i = e2
    return (a2r * a1r - a2i * a1i,
            a2r * a1i + a2i * a1r,
            a2r * b1r - a2i * b1i + b2r,
            a2r * b1i + a2i * b1r + b2i)


def s5_mixer(h, h0_re, h0_im, w_in, a_re, a_im, log_dt, b_re, b_im, c_re, c_im, d_skip,
             w_glu1, b_glu1, w_glu2, b_glu2, w_out):
    bn, seq_len, _ = h.shape
    xb, z = jnp.split(h @ w_in, 2, axis=-1)
    xg = xb.astype(jnp.float32).reshape(bn, seq_len, N_GROUPS_B, SSM_GROUP)
    abr, abi, bbr, bbi = zoh(a_re, a_im, log_dt, b_re, b_im)
    bu_re = jnp.einsum('blgk,gpk->blgp', xg, bbr)
    bu_im = jnp.einsum('blgk,gpk->blgp', xg, bbi)
    ar = jnp.broadcast_to(abr, bu_re.shape)
    ai = jnp.broadcast_to(abi, bu_re.shape)
    acr, aci, hr, hi = lax.associative_scan(_combine, (ar, ai, bu_re, bu_im), axis=1)
    if h0_re is not None:
        h0r = h0_re.astype(jnp.float32)[:, None]
        h0i = h0_im.astype(jnp.float32)[:, None]
        hr = hr + acr * h0r - aci * h0i
        hi = hi + acr * h0i + aci * h0r
    cr = c_re.astype(jnp.float32)
    ci = c_im.astype(jnp.float32)
    y = jnp.einsum('gkp,blgp->blgk', cr, hr) - jnp.einsum('gkp,blgp->blgk', ci, hi)
    y = y.reshape(bn, seq_len, EXP_B) + d_skip.astype(jnp.float32) * xb.astype(jnp.float32)
    y = jax.nn.gelu(y).astype(h.dtype)
    y = (y @ w_glu1 + b_glu1) * jax.nn.sigmoid(y @ w_glu2 + b_glu2)
    out = (y * jax.nn.silu(z)) @ w_out
    return out, hr[:, -1], hi[:, -1]


def _trunk(x, h0_re, h0_im, norm_pre, norm_post,
           w_in_a, ln_v_g, ln_v_b, w_s, b_s, w_out_a,
           w_in_b, a_re, a_im, log_dt, b_re, b_im, c_re, c_im, d_skip,
           w_glu1, b_glu1, w_glu2, b_glu2, w_out_b):
    v_rows, st_re, st_im = [], [], []
    for i in range(DEPTH):
        j = i // N_MIXERS
        hn = rmsnorm(x, norm_pre[i])
        if i % N_MIXERS == 0:
            out, v = chunk_gmlp(hn, w_in_a[j], ln_v_g[j], ln_v_b[j], w_s[j], b_s[j], w_out_a[j])
            v_rows.append(v)
        else:
            h0r = None if h0_re is None else h0_re[j]
            h0i = None if h0_im is None else h0_im[j]
            out, hr, hi = s5_mixer(hn, h0r, h0i, w_in_b[j], a_re[j], a_im[j], log_dt[j],
                                   b_re[j], b_im[j], c_re[j], c_im[j], d_skip[j],
                                   w_glu1[j], b_glu1[j], w_glu2[j], b_glu2[j], w_out_b[j])
            st_re.append(hr)
            st_im.append(hi)
        x = x + rmsnorm(out, norm_post[i])
    return x, jnp.stack(v_rows), jnp.stack(st_re), jnp.stack(st_im)


def setup_inputs(seed: int = 0) -> dict:
    key = jax.random.key(seed)
    ks = jax.random.split(key, 28)
    f32 = jnp.float32
    nrm = lambda k, s, sc: jax.random.normal(k, s, f32) * sc
    na, nb = N_CHUNK_LAYERS, N_SSM_LAYERS
    n_idx = jnp.arange(STATE_P, dtype=f32)
    return {
        "x_prompt": nrm(ks[0], (BATCH, SEQ, D_MODEL), 1.0),
        "x_sample": nrm(ks[1], (DEC_BATCH, DEC_SEQ, D_MODEL), 1.0),
        "state_ssm_re": nrm(ks[2], (nb, DEC_BATCH, N_GROUPS_B, STATE_P), 0.3),
        "state_ssm_im": nrm(ks[3], (nb, DEC_BATCH, N_GROUPS_B, STATE_P), 0.3),
        "norm_pre": 1.0 + nrm(ks[4], (DEPTH, D_MODEL), 0.02),
        "norm_post": 1.0 + nrm(ks[5], (DEPTH, D_MODEL), 0.02),
        "w_in_a": nrm(ks[6], (na, D_MODEL, 3 * EXP_A), D_MODEL ** -0.5),
        "ln_v_g": 1.0 + nrm(ks[7], (na, EXP_A), 0.02),
        "ln_v_b": nrm(ks[8], (na, EXP_A), 0.01),
        "w_s": nrm(ks[9], (na, N_GROUPS_A, CHUNK, CHUNK), CHUNK ** -0.5),
        "b_s": 1.0 + nrm(ks[10], (na, N_GROUPS_A, CHUNK), 0.1),
        "w_out_a": nrm(ks[11], (na, EXP_A, D_MODEL), EXP_A ** -0.5),
        "w_in_b": nrm(ks[12], (nb, D_MODEL, 2 * EXP_B), D_MODEL ** -0.5),
        "a_re": -0.5 + nrm(ks[13], (nb, N_GROUPS_B, STATE_P), 0.01),
        "a_im": jnp.pi * n_idx + nrm(ks[14], (nb, N_GROUPS_B, STATE_P), 0.01),
        "log_dt": jax.random.uniform(ks[15], (nb, N_GROUPS_B), f32, math.log(DT_MIN), math.log(DT_MAX)),
        "b_re": nrm(ks[16], (nb, N_GROUPS_B, STATE_P, SSM_GROUP), (2 * SSM_GROUP) ** -0.5),
        "b_im": nrm(ks[17], (nb, N_GROUPS_B, STATE_P, SSM_GROUP), (2 * SSM_GROUP) ** -0.5),
        "c_re": nrm(ks[18], (nb, N_GROUPS_B, SSM_GROUP, STATE_P), (2 * STATE_P) ** -0.5),
        "c_im": nrm(ks[19], (nb, N_GROUPS_B, SSM_GROUP, STATE_P), (2 * STATE_P) ** -0.5),
        "d_skip": nrm(ks[20], (nb, EXP_B), 1.0),
        "w_glu1": nrm(ks[21], (nb, EXP_B, EXP_B), EXP_B ** -0.5),
        "b_glu1": nrm(ks[22], (nb, EXP_B), 0.01),
        "w_glu2": nrm(ks[23], (nb, EXP_B, EXP_B), EXP_B ** -0.5),
        "b_glu2": nrm(ks[24], (nb, EXP_B), 0.01),
        "w_out_b": nrm(ks[25], (nb, EXP_B, D_MODEL), EXP_B ** -0.5),
    }


def reference(x_prompt, x_sample, state_ssm_re, state_ssm_im, norm_pre, norm_post,
              w_in_a, ln_v_g, ln_v_b, w_s, b_s, w_out_a,
              w_in_b, a_re, a_im, log_dt, b_re, b_im, c_re, c_im, d_skip,
              w_glu1, b_glu1, w_glu2, b_glu2, w_out_b):
    y_prompt, _, ssm_re_prompt, ssm_im_prompt = _trunk(
        x_prompt, None, None, norm_pre, norm_post,
        w_in_a, ln_v_g, ln_v_b, w_s, b_s, w_out_a,
        w_in_b, a_re, a_im, log_dt, b_re, b_im, c_re, c_im, d_skip,
        w_glu1, b_glu1, w_glu2, b_glu2, w_out_b)
    y_sample, chunk_v_sample, ssm_re_sample, ssm_im_sample = _trunk(
        x_sample, state_ssm_re, state_ssm_im, norm_pre, norm_post,
        w_in_a, ln_v_g, ln_v_b, w_s, b_s, w_out_a,
        w_in_b, a_re, a_im, log_dt, b_re, b_im, c_re, c_im, d_skip,
        w_glu1, b_glu1, w_glu2, b_glu2, w_out_b)
    return (y_prompt, y_sample, chunk_v_sample, ssm_re_prompt, ssm_im_prompt, ssm_re_sample, ssm_im_sample)
```

```cpp
#include <hip/hip_runtime.h>
#include <hip/hip_cooperative_groups.h>
#include <cstdio>
#include <type_traits>
namespace cg = cooperative_groups;

#ifndef FAST_GEMM
#define FAST_GEMM 1
#endif
#ifndef FAST_P2
#define FAST_P2 1
#endif

#define LAS __attribute__((address_space(3)))
typedef unsigned short bf16_t;
typedef short bf16x8 __attribute__((ext_vector_type(8)));
typedef float f32x4 __attribute__((ext_vector_type(4)));
typedef unsigned u32x4 __attribute__((ext_vector_type(4)));
typedef unsigned u32x2 __attribute__((ext_vector_type(2)));

constexpr int T_ALL = 16896, T_PR = 16384, D = 1024, EA = 2048, NCHK = 512, XHW = 640;
constexpr float EPS = 1e-6f;
constexpr size_t MiB = 1u << 20;
constexpr size_t OFF_WINA = 0, OFF_WOUTA = 24 * MiB, OFF_WINB = 32 * MiB, OFF_WGLU = 40 * MiB, OFF_WOUTB = 48 * MiB;
constexpr size_t OFF_SMALL = 52 * MiB;
constexpr size_t OFF_WSB = OFF_SMALL, OFF_RS = OFF_SMALL + 512 * 1024, OFF_VSTAT = 245 * MiB, OFF_OSQ = 248 * MiB, OFF_BAR = 253 * MiB, OFF_XBS = 254 * MiB,
                 OFF_COEF = OFF_SMALL + 896 * 1024, OFF_TABE = OFF_SMALL + 1 * MiB, OFF_KTAB = OFF_SMALL + 4 * MiB;
constexpr size_t OFF_HN = 60 * MiB, OFF_UZ = 93 * MiB, OFF_TV = 93 * MiB, OFF_WG = 133 * MiB, OFF_XH = 141 * MiB, OFF_VT = 159 * MiB,
                 OFF_ORA = 192 * MiB, OFF_SZ = 192 * MiB, OFF_ORB = 141 * MiB, OFF_S = 225 * MiB;
constexpr size_t OUT_CV = 17301504, OUT_RP = 19398656, OUT_IP = 19464192, OUT_RS = 19529728, OUT_IS = 20578304;

struct Params { const float* in[26]; float* out; unsigned char* ws; };

__device__ __forceinline__ int tidx() { int t = threadIdx.x; asm volatile("" : "+v"(t)); return t; }
template <int CTRL> __device__ __forceinline__ float dpp_f(float v) { return __int_as_float(__builtin_amdgcn_update_dpp(0, __float_as_int(v), CTRL, 0xf, 0xf, true)); }
__device__ __forceinline__ float red16(float v) { v += dpp_f<0xB1>(v); v += dpp_f<0x4E>(v); v += dpp_f<0x141>(v); v += dpp_f<0x140>(v); return v; }
__device__ __forceinline__ float shfl_xor_f(float v, int o) { const int l = tidx() & 63; return __int_as_float(__builtin_amdgcn_ds_bpermute((l ^ o) << 2, __float_as_int(v))); }
__device__ __forceinline__ float zero_f() { float z = 0.f; asm volatile("" : "+v"(z)); return z; }
__device__ __forceinline__ int bidx() { int b = blockIdx.x; asm volatile("" : "+s"(b)); return b; }
__device__ __forceinline__ unsigned pk2(float lo, float hi) { unsigned r; asm("v_cvt_pk_bf16_f32 %0, %1, %2" : "=v"(r) : "v"(lo), "v"(hi)); return r; }
__device__ __forceinline__ float bf2f(bf16_t b) { return __uint_as_float(((unsigned)b) << 16); }
__device__ __forceinline__ float bflo(unsigned w) { return __uint_as_float(w << 16); }
__device__ __forceinline__ float bfhi(unsigned w) { return __uint_as_float(w & 0xffff0000u); }
__device__ __forceinline__ bf16_t f2bf(float f) { return (bf16_t)(pk2(f, 0.f) & 0xffffu); }
__device__ __forceinline__ u32x4 pk8(const float (&v)[8]) { u32x4 w; w.x = pk2(v[0], v[1]); w.y = pk2(v[2], v[3]); w.z = pk2(v[4], v[5]); w.w = pk2(v[6], v[7]); return w; }
__device__ __forceinline__ void unpk8(u32x4 w, float (&v)[8]) { v[0] = bflo(w.x); v[1] = bfhi(w.x); v[2] = bflo(w.y); v[3] = bfhi(w.y); v[4] = bflo(w.z); v[5] = bfhi(w.z); v[6] = bflo(w.w); v[7] = bfhi(w.w); }
__device__ __forceinline__ float silu_f(float z) { return z * __builtin_amdgcn_rcpf(1.f + __expf(-z)); }
__device__ __forceinline__ float sigmoid_f(float z) { return __builtin_amdgcn_rcpf(1.f + __expf(-z)); }
__device__ __forceinline__ float gelu_tanh_f(float x) { const float u = 0.7978845608f * (x + 0.044715f * x * x * x); return x * __builtin_amdgcn_rcpf(1.f + __expf(-2.f * u)); }
__device__ __forceinline__ void row2cs(int row, int& chunk, int& s) { if (row < T_PR) { chunk = row >> 5; s = row & 31; } else { const int r = row - T_PR; chunk = 512 + (r >> 2); s = r & 3; } }


#define XB_TMO      128
#define XB_XCNT(j)  (256  + 64 * (j))
#define XB_XSUB(j)  (1280 + 64 * (j))
#define XB_XGEN(j)  (2304 + 64 * (j))
#define XB_TOP      3328
#define XB_TOPGEN   3392
#define XCD_BAR_WORDS 3456
#define XB_SPIN_CAP (1u << 22)
__device__ __forceinline__ unsigned xb_ld(unsigned* p)              { return __hip_atomic_load(p, __ATOMIC_RELAXED, __HIP_MEMORY_SCOPE_AGENT); }
__device__ __forceinline__ unsigned xb_add(unsigned* p, unsigned v) { return __hip_atomic_fetch_add(p, v, __ATOMIC_RELAXED, __HIP_MEMORY_SCOPE_AGENT); }
__device__ __forceinline__ unsigned xb_xcc_id() { return (unsigned)__builtin_amdgcn_s_getreg((3 << 11) | 20) & 0xFu; }
#define XB_SPIN(cond, bar) do { unsigned _sp = 0; while (cond) { __builtin_amdgcn_s_sleep(1); \
    if ((++_sp & 255u) == 0u) { if (xb_ld(&(bar)[XB_TMO])) break; if (_sp > XB_SPIN_CAP) { atomicAdd(&(bar)[XB_TMO], 1u); break; } } } } while (0)
struct XcdBarrier { unsigned* bar; unsigned x; volatile LAS unsigned* st; };
__device__ __forceinline__ XcdBarrier xcd_barrier_post(unsigned* bar, volatile LAS unsigned* st) {
    XcdBarrier b; b.bar = bar; b.x = xb_xcc_id(); b.st = st;
    if (tidx() == 0) (void)xb_add(&bar[XB_XCNT(b.x)], 1u);
    return b;
}
__device__ __forceinline__ void xcd_barrier_complete(unsigned* bar, unsigned x, unsigned& nloc, unsigned& nx) {
    const unsigned G = gridDim.x * gridDim.y * gridDim.z;
    unsigned sum, cnt, mine, sp = 0u;
    for (;;) {
        sum = 0u; cnt = 0u; mine = 0u;
#pragma unroll
        for (unsigned j = 0; j < 16; ++j) { const unsigned c = xb_ld(&bar[XB_XCNT(j)]); sum += c; cnt += (c > 0u) ? 1u : 0u; mine = (j == x) ? c : mine; }
        if (sum == G) break;
        __builtin_amdgcn_s_sleep(1);
        if ((++sp & 255u) == 0u) { if (xb_ld(&bar[XB_TMO])) break; if (sp > XB_SPIN_CAP) { atomicAdd(&bar[XB_TMO], 1u); break; } }
    }
    nloc = mine > 0u ? mine : 1u; nx = cnt > 0u ? cnt : 1u;
}
__device__ __forceinline__ void xcd_barrier(const XcdBarrier& b) {
    asm volatile("s_waitcnt vmcnt(0)" ::: "memory");
    __syncthreads();
    if (tidx() == 0) {
        unsigned* bar = b.bar; unsigned bx = b.x; asm volatile("" : "+s"(bx));
        __builtin_amdgcn_s_waitcnt(0);
        unsigned nloc = b.st[0], nx = b.st[1];
        if (nloc == 0u) { xcd_barrier_complete(bar, bx, nloc, nx); b.st[0] = nloc; b.st[1] = nx; }
        const unsigned old = xb_add(&bar[XB_XSUB(bx)], 1u);
        const unsigned gen = old / nloc;
        if (old + 1u == (gen + 1u) * nloc) {
            __builtin_amdgcn_fence(__ATOMIC_RELEASE, "agent");
            asm volatile("s_waitcnt vmcnt(0)" ::: "memory");
            const unsigned og = xb_add(&bar[XB_TOP], 1u);
            const unsigned tg = og / nx;
            if (og + 1u == (tg + 1u) * nx) xb_add(&bar[XB_TOPGEN], 1u);
            else XB_SPIN(xb_ld(&bar[XB_TOPGEN]) == tg, bar);
            __builtin_amdgcn_fence(__ATOMIC_ACQUIRE, "agent");
            xb_add(&bar[XB_XGEN(bx)], 1u);
            asm volatile("s_waitcnt vmcnt(0)" ::: "memory");
        } else {
            XB_SPIN(xb_ld(&bar[XB_XGEN(bx)]) == gen, bar);
            __builtin_amdgcn_fence(__ATOMIC_ACQUIRE, "agent");
            asm volatile("s_waitcnt vmcnt(0)" ::: "memory");
        }
    }
    __syncthreads();
}

struct GemmD { const bf16_t* A; const bf16_t* Bt; int lda, ldb, nM, nN, nB, K; long long sA, sB; int xr; };

struct EpiUZ {
    bf16_t* uz;
    static constexpr int NPASS = 1;
    __device__ __forceinline__ void begin() {}
    template <bool FAST> __device__ __forceinline__ void row(int, int row, int pn, int c8, const float (&v0)[8], const float (&v1)[8]) {
        float o[8];
#pragma unroll
        for (int i = 0; i < 8; ++i) o[i] = v0[i] * silu_f(v1[i]);
        *(u32x4*)(uz + (size_t)row * EA + 128 * pn + c8) = pk8(o);
    }
    template <bool FAST> __device__ __forceinline__ void end(int, int, int, int) {}
};
struct EpiVT {
    static constexpr int NPASS = 3;
    bf16_t* vT; float* vstat; int pass; float cs[8], cq[8];
    __device__ __forceinline__ void begin() {
#pragma unroll
        for (int i = 0; i < 8; ++i) { cs[i] = 0.f; cq[i] = 0.f; } }
    template <bool FAST> __device__ __forceinline__ void row(int, int row, int pn, int c8, const float (&v0)[8], const float (&v1)[8]) {
        if (!FAST || pass == 0) { *(u32x4*)(vT + (size_t)row * T_ALL + 256 * pn + c8) = pk8(v0); *(u32x4*)(vT + (size_t)row * T_ALL + 256 * pn + 128 + c8) = pk8(v1); return; }
        if (pass == 1) {
#pragma unroll
            for (int i = 0; i < 8; ++i) { cs[i] += v0[i]; cq[i] += v0[i] * v0[i]; asm volatile("" : "+v"(cs[i]), "+v"(cq[i])); } }
        else {
#pragma unroll
            for (int i = 0; i < 8; ++i) { cs[i] += v1[i]; cq[i] += v1[i] * v1[i]; asm volatile("" : "+v"(cs[i]), "+v"(cq[i])); } }
    }
    template <bool FAST> __device__ __forceinline__ void end(int, int pm, int pn, int c8) {
        if (FAST && pass > 0) {
#pragma unroll
            for (int i = 0; i < 8; ++i) {
                cs[i] = red16(cs[i]); cq[i] = red16(cq[i]); }
            if ((tidx() & 15) == 0) { const int slot = pm * 2 + ((tidx() >> 8) & 1);
#pragma unroll
                for (int i = 0; i < 8; ++i) { const int tok = 256 * pn + (pass - 1) * 128 + c8 + i; *(float2*)(vstat + ((size_t)tok * 16 + slot) * 2) = make_float2(cs[i], cq[i]); } }
        }
    }
};
struct EpiOut {
    bf16_t* o; float* osq;
    static constexpr int NPASS = 1;
    __device__ __forceinline__ void begin() {}
    template <bool FAST> __device__ __forceinline__ void row(int, int row, int pn, int c8, const float (&v0)[8], const float (&v1)[8]) {
        *(u32x4*)(o + (size_t)row * D + 256 * pn + c8) = pk8(v0);
        *(u32x4*)(o + (size_t)row * D + 256 * pn + 128 + c8) = pk8(v1);
    }
    template <bool FAST> __device__ __forceinline__ void end(int, int, int, int) {}
};
struct EpiPart {
    static constexpr int NPASS = 1;
    float* P;
    __device__ __forceinline__ void begin() {}
    template <bool FAST> __device__ __forceinline__ void row(int b, int row, int pn, int c8, const float (&v0)[8], const float (&v1)[8]) {
        float* q = P + ((size_t)b * 512 + row) * D + 256 * pn + c8;
        *(f32x4*)q = (f32x4){v0[0], v0[1], v0[2], v0[3]}; *(f32x4*)(q + 4) = (f32x4){v0[4], v0[5], v0[6], v0[7]};
        *(f32x4*)(q + 128) = (f32x4){v1[0], v1[1], v1[2], v1[3]}; *(f32x4*)(q + 132) = (f32x4){v1[4], v1[5], v1[6], v1[7]};
    }
    template <bool FAST> __device__ __forceinline__ void end(int, int, int, int) {}
};
struct EpiInB {
    bf16_t* xh; bf16_t* sz; bf16_t* xbs;
    static constexpr int NPASS = 1;
    __device__ __forceinline__ void begin() {}
    template <bool FAST> __device__ __forceinline__ void row(int, int row, int pn, int c8, const float (&v0)[8], const float (&v1)[8]) {
        if (pn < 4) {
            const int c0 = 256 * pn + c8, c1 = c0 + 128;
            if (row < T_PR) { const int chunk = row >> 5, s = row & 31;
                *(u32x4*)(xh + ((size_t)(c0 >> 4) * NCHK + chunk) * XHW + s * 16 + (c0 & 15)) = pk8(v0);
                *(u32x4*)(xh + ((size_t)(c1 >> 4) * NCHK + chunk) * XHW + s * 16 + (c1 & 15)) = pk8(v1);
            } else { *(u32x4*)(xbs + (size_t)(row - T_PR) * D + c0) = pk8(v0); *(u32x4*)(xbs + (size_t)(row - T_PR) * D + c1) = pk8(v1); }
        } else {
            float a[8], b[8];
#pragma unroll
            for (int i = 0; i < 8; ++i) { a[i] = silu_f(v0[i]); b[i] = silu_f(v1[i]); }
            const int c0 = 256 * (pn - 4) + c8;
            *(u32x4*)(sz + (size_t)row * D + c0) = pk8(a);
            *(u32x4*)(sz + (size_t)row * D + c0 + 128) = pk8(b);
        }
    }
    template <bool FAST> __device__ __forceinline__ void end(int, int, int, int) {}
};
struct EpiS1 {
    float* S;
    static constexpr int NPASS = 1;
    __device__ __forceinline__ void begin() {}
    template <bool FAST> __device__ __forceinline__ void row(int g, int row, int, int c8, const float (&v0)[8], const float (&)[8]) {
        if (row < NCHK) { float* p = S + ((size_t)g * NCHK + row) * 128 + c8; *(f32x4*)p = (f32x4){v0[0], v0[1], v0[2], v0[3]}; *(f32x4*)(p + 4) = (f32x4){v0[4], v0[5], v0[6], v0[7]}; }
    }
    template <bool FAST> __device__ __forceinline__ void end(int, int, int, int) {}
};
struct EpiS3 {
    static constexpr int NPASS = 1;
    bf16_t* y;
    __device__ __forceinline__ void begin() {}
    __device__ __forceinline__ void one(int g, int chunk, int col, const float (&v)[8]) {
        const int t = col >> 4, j0 = col & 15; int tok;
        tok = chunk * 32 + t;
        float o[8];
#pragma unroll
        for (int i = 0; i < 8; ++i) o[i] = gelu_tanh_f(v[i]);
        *(u32x4*)(y + (size_t)tok * D + 16 * g + j0) = pk8(o);
    }
    template <bool FAST> __device__ __forceinline__ void row(int g, int row, int pn, int c8, const float (&v0)[8], const float (&v1)[8]) {
        if (row >= NCHK) return;
        one(g, row, 256 * pn + c8, v0); one(g, row, 256 * pn + 128 + c8, v1);
    }
    template <bool FAST> __device__ __forceinline__ void end(int, int, int, int) {}
};
struct EpiGlu {
    bf16_t* sz; const float* b1; const float* b2;
    static constexpr int NPASS = 1;
    __device__ __forceinline__ void begin() {}
    template <bool FAST> __device__ __forceinline__ void row(int, int row, int pn, int c8, const float (&v0)[8], const float (&v1)[8]) {
        const int c = 128 * pn + c8; bf16_t* p = sz + (size_t)row * D + c;
        float z[8], o[8]; unpk8(*(const u32x4*)p, z);
        const f32x4 p0 = *(const f32x4*)(b1 + c), p1 = *(const f32x4*)(b1 + c + 4), q0 = *(const f32x4*)(b2 + c), q1 = *(const f32x4*)(b2 + c + 4);
        const float bb1[8] = {p0[0], p0[1], p0[2], p0[3], p1[0], p1[1], p1[2], p1[3]}, bb2[8] = {q0[0], q0[1], q0[2], q0[3], q1[0], q1[1], q1[2], q1[3]};
#pragma unroll
        for (int i = 0; i < 8; ++i) o[i] = (v0[i] + bb1[i]) * sigmoid_f(v1[i] + bb2[i]) * z[i];
        *(u32x4*)p = pk8(o);
    }
    template <bool FAST> __device__ __forceinline__ void end(int, int, int, int) {}
    __device__ __forceinline__ void rowz(u32x4 zw, const float (&bb1)[8], const float (&bb2)[8], int row, int pn, int c8, const float (&v0)[8], const float (&v1)[8]) {
        float z[8], o[8]; unpk8(zw, z);
#pragma unroll
        for (int i = 0; i < 8; ++i) o[i] = (v0[i] + bb1[i]) * sigmoid_f(v1[i] + bb2[i]) * z[i];
        *(u32x4*)(sz + (size_t)row * D + 128 * pn + c8) = pk8(o);
    }
};

__device__ __forceinline__ float dot8(const float (&a)[8], u32x4 w) { float b[8]; unpk8(w, b); float s = 0.f;
#pragma unroll
    for (int i = 0; i < 8; ++i) s += a[i] * b[i];
    return s; }
template <class Epi> __device__ void gemm_naive(const GemmD g, Epi E) {
    const long long items = (long long)g.nB * g.nM * g.nN * 4096, nth = (long long)gridDim.x * blockDim.x;
    for (long long it = (long long)bidx() * blockDim.x + tidx(); it < items; it += nth) {
        const int rl = (int)(it & 255), c8 = (int)((it >> 8) & 15) * 8; const long long u = it >> 12;
        const int pm = (int)(u % g.nM); const long long u2 = u / g.nM; const int pn = (int)(u2 % g.nN), b = (int)(u2 / g.nN);
        const int row = pm * 256 + rl;
        const bf16_t* a = g.A + (size_t)b * g.sA + (size_t)row * g.lda;
        const bf16_t* bt = g.Bt + (size_t)b * g.sB + (size_t)(pn * 256 + c8) * g.ldb;
        float v0[8], v1[8];
#pragma unroll
        for (int i = 0; i < 8; ++i) { v0[i] = 0.f; v1[i] = 0.f; }
        for (int k = 0; k < g.K; k += 8) {
            float af[8]; unpk8(*(const u32x4*)(a + k), af);
#pragma unroll
            for (int i = 0; i < 8; ++i) { v0[i] += dot8(af, *(const u32x4*)(bt + (size_t)i * g.ldb + k)); v1[i] += dot8(af, *(const u32x4*)(bt + (size_t)(128 + i) * g.ldb + k)); }
        }
        E.begin(); E.template row<false>(b, row, pn, c8, v0, v1);
    }
}

constexpr int BM = 256, BK = 64, HALF = 128, HTB = HALF * BK * 2, STAGE_BYTES = 8 * HTB, NXCD = 8, WGM = 8;
__device__ __forceinline__ int lds_byte(int r, int c) { const int st = (r >> 4) * 2 + (c >> 5), rr = r & 15, cc = c & 31, ob = rr * 64 + cc * 2; return st * 1024 + (ob ^ (((ob >> 9) & 1) << 5)); }
__device__ __forceinline__ void stage_rc(int b, int& R, int& C) { const int st = b / 1024, sb = b % 1024, swz = sb ^ (((sb >> 9) & 1) << 5); R = (st >> 1) * 16 + swz / 64; C = (st & 1) * 32 + (swz % 64) / 2; }
__device__ __forceinline__ int perm32(int rho) { const int n = rho >> 4, i = rho & 15; return 8 * (i >> 2) + 4 * n + (i & 3); }
struct Unit { int b, pm, pn, w; };
struct Sched {
    int nM, nN, nB, nwg, G, c, n1, nM2, nN2, nwg2, xr;
    __device__ void init(const GemmD& g, const GemmD& g2, bool two, int G_, int c_) { nM = g.nM; nN = g.nN; nB = g.nB; nwg = nM * nN; G = G_; c = c_; n1 = nwg * nB; xr = g.xr;
        nM2 = two ? g2.nM : 0; nN2 = two ? g2.nN : 0; nwg2 = nM2 * nN2; }
    __device__ static void xcdmap(int L, int nM_, int nN_, int nwg_, Unit& u) {
        int wgid = L; { const int q = nwg_ / NXCD, r = nwg_ % NXCD, xcd = wgid % NXCD, off = wgid / NXCD; wgid = (xcd < r ? xcd * (q + 1) : r * (q + 1) + (xcd - r) * q) + off; }
        const int nig = WGM * nN_, gid = wgid / nig, fm = gid * WGM, gsz = (nM_ - fm) < WGM ? (nM_ - fm) : WGM;
        u.b = 0; u.pm = fm + ((wgid % nig) % gsz); u.pn = (wgid % nig) / gsz; }
    __device__ bool next(int i, Unit& u) const {
        const long L = (long)i * G + c; if (L >= (long)n1 + nwg2) return false;
        if (L >= n1) { u.w = 1; xcdmap((int)(L - n1), nM2, nN2, nwg2, u); return true; }
        u.w = 0;
        if (nB == 1) xcdmap((int)L, nM, nN, nwg, u);
        else { const int Lr = xr ? (int)((L & 7) * (n1 >> 3) + (L >> 3)) : (int)L;
            u.b = Lr / nwg; const int r = Lr % nwg; u.pm = r % nM; u.pn = r / nM; }
        return true;
    }
};
template <class Epi, class Epi2, bool TWO>
__device__ __forceinline__ void gemm_fast(LAS unsigned char* lds, const GemmD g, Epi E, const GemmD g2, Epi2 E2) {
    Sched S; S.init(g, g2, TWO, gridDim.x, bidx());
    int tid_ = tidx();
    const int tid = tid_, wid = __builtin_amdgcn_readfirstlane(tid >> 6), lane = tid & 63, wr = wid >> 2, wc = wid & 3, fr = lane & 15, fq = lane >> 4;
    const int K = g.K, nt = K / BK;
    unsigned voffA[2], voffB[2];
#pragma unroll
    for (int i = 0; i < 2; ++i) { int R, C; stage_rc(tid * 16 + i * 8192, R, C); const int Rb = (R & ~31) + perm32(R & 31);
        voffA[i] = (unsigned)(R * g.lda + C) * 2u; voffB[i] = (unsigned)(Rb * g.ldb + C) * 2u; }
    const size_t kstep = (size_t)(BK * 2);
    const size_t hstepA = (size_t)HALF * g.lda * 2, hstepB = (size_t)HALF * g.ldb * 2, tstepA = 2 * hstepA, tstepB = 2 * hstepB;
    const unsigned ldsw = (unsigned)wid * 1024u;
    const int aoff = lds_byte(wr * 64 + fr, fq * 8), boff = lds_byte(wc * 32 + fr, fq * 8);
#define PG8_SA(b, h) (((b) * 2 + (h)) * HTB)
#define PG8_SB(b, h) ((4 + (b) * 2 + (h)) * HTB)
#define PG8_STAGE(bufoff, gbase, voff) do { _Pragma("unroll") for (int _i = 0; _i < 2; ++_i) \
        __builtin_amdgcn_global_load_lds((const unsigned*)((const char*)(gbase) + (voff)[_i]), (LAS unsigned*)(lds + (bufoff) + ldsw + _i * 8192), 16, 0, 0); } while (0)
#define PG8_LDA(dst, b, h) do { _Pragma("unroll") for (int m = 0; m < 4; ++m) _Pragma("unroll") for (int k = 0; k < 2; ++k) dst[m][k] = *(const LAS bf16x8*)(lds + PG8_SA(b, h) + aoff + m * 2048 + k * 1024); } while (0)
#define PG8_LDB(dst, b, h) do { _Pragma("unroll") for (int n = 0; n < 2; ++n) _Pragma("unroll") for (int k = 0; k < 2; ++k) dst[n][k] = *(const LAS bf16x8*)(lds + PG8_SB(b, h) + boff + n * 2048 + k * 1024); } while (0)
#define PG8_MMA(ai, bj, At, Bt) do { __builtin_amdgcn_s_setprio(1); _Pragma("unroll") for (int m = 0; m < 4; ++m) _Pragma("unroll") for (int n = 0; n < 2; ++n) _Pragma("unroll") for (int k = 0; k < 2; ++k) \
        acc[ai][bj][m][n] = __builtin_amdgcn_mfma_f32_16x16x32_bf16(Bt[n][k], At[m][k], acc[ai][bj][m][n], 0, 0, 0); __builtin_amdgcn_s_setprio(0); } while (0)
#define PG8_WAIT_V(n) asm volatile("s_waitcnt vmcnt(" #n ")" ::: "memory")
#define PG8_WAIT_L(n) asm volatile("s_waitcnt lgkmcnt(" #n ")" ::: "memory")
#define PG8_BAR __builtin_amdgcn_s_barrier()
#define PG8_SCHED __builtin_amdgcn_sched_barrier(0)
    Unit cur, nxt; int ui = 0;
    if (!S.next(0, cur)) return;
    f32x4 acc[2][2][4][2];
#pragma unroll
    for (int a = 0; a < 2; ++a)
#pragma unroll
        for (int b = 0; b < 2; ++b)
#pragma unroll
            for (int m = 0; m < 4; ++m)
#pragma unroll
                for (int n = 0; n < 2; ++n) { const float z = zero_f(); acc[a][b][m][n] = (f32x4){z, z, z, z}; }
    bf16x8 At[4][2], B0[2][2], B1[2][2];
    const char* cA = ((TWO && cur.w) ? (const char*)g2.A : (const char*)g.A + (size_t)cur.b * g.sA * 2) + (size_t)cur.pm * tstepA;
    const char* cB = ((TWO && cur.w) ? (const char*)g2.Bt : (const char*)g.Bt + (size_t)cur.b * g.sB * 2) + (size_t)cur.pn * tstepB;
    PG8_STAGE(PG8_SB(0, 0), cB, voffB); PG8_STAGE(PG8_SA(0, 0), cA, voffA); PG8_STAGE(PG8_SB(0, 1), cB + hstepB, voffB); PG8_STAGE(PG8_SA(0, 1), cA + hstepA, voffA);
    if (wr == 1) PG8_BAR;
    PG8_WAIT_V(4); PG8_BAR;
    PG8_STAGE(PG8_SB(1, 0), cB + kstep, voffB); PG8_STAGE(PG8_SA(1, 0), cA + kstep, voffA); PG8_STAGE(PG8_SB(1, 1), cB + hstepB + kstep, voffB);
    PG8_WAIT_V(6); PG8_BAR;
    for (;;) {
        const bool has_next = S.next(ui + 1, nxt);
        const char* nA = has_next ? ((TWO && nxt.w) ? (const char*)g2.A : (const char*)g.A + (size_t)nxt.b * g.sA * 2) + (size_t)nxt.pm * tstepA : cA;
        const char* nB = has_next ? ((TWO && nxt.w) ? (const char*)g2.Bt : (const char*)g.Bt + (size_t)nxt.b * g.sB * 2) + (size_t)nxt.pn * tstepB : cB;
        for (int t = 0; t < nt; t += 2) {
            const bool last = (t == nt - 2);
            const char* a1 = cA + (size_t)(t + 1) * kstep;
            const char* a2 = last ? nA : cA + (size_t)(t + 2) * kstep; const char* b2 = last ? nB : cB + (size_t)(t + 2) * kstep;
            const char* a3 = a2 + kstep; const char* b3 = b2 + kstep;
            PG8_LDB(B0, 0, 0); PG8_SCHED; PG8_LDA(At, 0, 0); PG8_STAGE(PG8_SA(1, 1), a1 + hstepA, voffA);
            PG8_WAIT_L(8); PG8_BAR; PG8_WAIT_L(0); PG8_MMA(0, 0, At, B0); PG8_BAR; PG8_SCHED;
            PG8_LDB(B1, 0, 1); PG8_STAGE(PG8_SB(0, 0), b2, voffB);
            PG8_BAR; PG8_WAIT_L(0); PG8_MMA(0, 1, At, B1); PG8_BAR;
            PG8_LDA(At, 0, 1); PG8_STAGE(PG8_SA(0, 0), a2, voffA);
            PG8_BAR; PG8_WAIT_L(0); PG8_MMA(1, 0, At, B0); PG8_BAR; PG8_SCHED;
            PG8_STAGE(PG8_SB(0, 1), b2 + hstepB, voffB);
            PG8_WAIT_V(6); PG8_BAR; PG8_MMA(1, 1, At, B1); PG8_BAR;
            PG8_LDB(B0, 1, 0); PG8_SCHED; PG8_LDA(At, 1, 0); PG8_STAGE(PG8_SA(0, 1), a2 + hstepA, voffA);
            PG8_WAIT_L(8); PG8_BAR; PG8_WAIT_L(0); PG8_MMA(0, 0, At, B0); PG8_BAR; PG8_SCHED;
            PG8_LDB(B1, 1, 1); PG8_STAGE(PG8_SB(1, 0), b3, voffB);
            PG8_BAR; PG8_WAIT_L(0); PG8_MMA(0, 1, At, B1); PG8_BAR;
            PG8_LDA(At, 1, 1); PG8_STAGE(PG8_SA(1, 0), a3, voffA);
            PG8_BAR; PG8_WAIT_L(0); PG8_MMA(1, 0, At, B0); PG8_BAR; PG8_SCHED;
            PG8_STAGE(PG8_SB(1, 1), b3 + hstepB, voffB);
            PG8_WAIT_V(6); PG8_BAR; PG8_MMA(1, 1, At, B1); PG8_BAR;
        }
        int fr_e = fr, fq_e = fq; asm volatile("" : "+v"(fr_e), "+v"(fq_e));
        auto do_epi = [&](auto& EE) {
            using EpiT = typename std::remove_reference<decltype(EE)>::type;
            if constexpr (std::is_same<EpiT, EpiGlu>::value) {
                u32x4 zr[8]; float bb1[8], bb2[8];
                { const int c = 128 * cur.pn + wc * 32 + fq_e * 8; const f32x4 p0 = *(const f32x4*)(EE.b1 + c), p1 = *(const f32x4*)(EE.b1 + c + 4), q0 = *(const f32x4*)(EE.b2 + c), q1 = *(const f32x4*)(EE.b2 + c + 4);
#pragma unroll
                  for (int i = 0; i < 4; ++i) { bb1[i] = p0[i]; bb1[4 + i] = p1[i]; bb2[i] = q0[i]; bb2[4 + i] = q1[i]; } }
#pragma unroll
                for (int ai = 0; ai < 2; ++ai)
#pragma unroll
                    for (int m = 0; m < 4; ++m) zr[ai * 4 + m] = *(const u32x4*)(EE.sz + (size_t)(cur.pm * BM + ai * HALF + wr * 64 + m * 16 + fr_e) * D + 128 * cur.pn + wc * 32 + fq_e * 8);
#pragma unroll
                for (int ai = 0; ai < 2; ++ai)
#pragma unroll
                    for (int m = 0; m < 4; ++m) {
                        const float v0[8] = {acc[ai][0][m][0][0], acc[ai][0][m][0][1], acc[ai][0][m][0][2], acc[ai][0][m][0][3], acc[ai][0][m][1][0], acc[ai][0][m][1][1], acc[ai][0][m][1][2], acc[ai][0][m][1][3]};
                        const float v1[8] = {acc[ai][1][m][0][0], acc[ai][1][m][0][1], acc[ai][1][m][0][2], acc[ai][1][m][0][3], acc[ai][1][m][1][0], acc[ai][1][m][1][1], acc[ai][1][m][1][2], acc[ai][1][m][1][3]};
                        int fr_i = fr_e, fq_i = fq_e; asm volatile("" : "+v"(fr_i), "+v"(fq_i));
                        EE.rowz(zr[ai * 4 + m], bb1, bb2, cur.pm * BM + ai * HALF + wr * 64 + m * 16 + fr_i, cur.pn, wc * 32 + fq_i * 8, v0, v1);
                        __builtin_amdgcn_sched_barrier(0);
                    }
            } else
            {
#pragma unroll
            for (int pass = 0; pass < EpiT::NPASS; ++pass) {
                if constexpr (EpiT::NPASS > 1) EE.pass = pass;
                EE.begin();
#pragma unroll
                for (int ai = 0; ai < 2; ++ai)
#pragma unroll
                    for (int m = 0; m < 4; ++m) {
                        const float v0[8] = {acc[ai][0][m][0][0], acc[ai][0][m][0][1], acc[ai][0][m][0][2], acc[ai][0][m][0][3], acc[ai][0][m][1][0], acc[ai][0][m][1][1], acc[ai][0][m][1][2], acc[ai][0][m][1][3]};
                        const float v1[8] = {acc[ai][1][m][0][0], acc[ai][1][m][0][1], acc[ai][1][m][0][2], acc[ai][1][m][0][3], acc[ai][1][m][1][0], acc[ai][1][m][1][1], acc[ai][1][m][1][2], acc[ai][1][m][1][3]};
                        int fr_i = fr_e, fq_i = fq_e; asm volatile("" : "+v"(fr_i), "+v"(fq_i));
                        EE.template row<true>(cur.b, cur.pm * BM + ai * HALF + wr * 64 + m * 16 + fr_i, cur.pn, wc * 32 + fq_i * 8, v0, v1);
                        if (m & 1) { asm volatile("" ::: "memory"); __builtin_amdgcn_sched_barrier(0); }
                    }
                EE.template end<true>(cur.b, cur.pm, cur.pn, wc * 32 + fq_e * 8);
            }
            }
        };
        if (TWO && cur.w) do_epi(E2); else do_epi(E);
        if (!has_next) break;
#pragma unroll
        for (int a = 0; a < 2; ++a)
#pragma unroll
            for (int b = 0; b < 2; ++b)
#pragma unroll
                for (int m = 0; m < 4; ++m)
#pragma unroll
                    for (int n = 0; n < 2; ++n) { const float z = zero_f(); acc[a][b][m][n] = (f32x4){z, z, z, z}; }
        cur = nxt; cA = nA; cB = nB; ++ui;
    }
    PG8_WAIT_V(0);
    if (wr == 0) PG8_BAR;
    PG8_BAR;
#undef PG8_SA
#undef PG8_SB
#undef PG8_STAGE
#undef PG8_LDA
#undef PG8_LDB
#undef PG8_MMA
#undef PG8_WAIT_V
#undef PG8_WAIT_L
#undef PG8_BAR
#undef PG8_SCHED
}
#ifndef FMASK
#define FMASK 0xff
#endif
template <int ID, class Epi> __device__ __forceinline__ void run_gemm(LAS unsigned char* lds, const GemmD& g, const Epi& E) {
#if FAST_GEMM
#ifndef PROBE_MASK
#define PROBE_MASK 0
#endif
    for (int r = 0; r < (((PROBE_MASK >> ID) & 1) ? 2 : 1); ++r) { if ((FMASK >> ID) & 1) gemm_fast<Epi, Epi, false>(lds, g, E, g, E); else gemm_naive<Epi>(g, E); }
#else
    gemm_naive<Epi>(g, E);
#endif
}

__device__ __forceinline__ int nmap(int kind, int n) {
    if (kind == 0) { if (n < 2048) return 256 * (n >> 7) + (n & 127); if (n < 4096) return 4096 + (n - 2048); const int c = n - 4096; return 256 * (c >> 7) + 128 + (c & 127); }
    if (kind == 3) return 256 * (n >> 7) + (n & 127);
    if (kind == 4) return 256 * (n >> 7) + 128 + (n & 127);
    return n;
}
struct WTile { const float* src; bf16_t* dst; int kind, K, N, k0, n0; };
__device__ __forceinline__ WTile wtile(const Params& p, int tt) {
    WTile w; const int j = tt / 3328; int r = tt % 3328;
    if (r < 1536) { w.kind = 0; w.K = 1024; w.N = 6144; w.src = p.in[6] + (size_t)j * 1024 * 6144; w.dst = (bf16_t*)(p.ws + OFF_WINA) + (size_t)j * 6144 * 1024; }
    else if (r < 2048) { r -= 1536; w.kind = 1; w.K = 2048; w.N = 1024; w.src = p.in[11] + (size_t)j * 2048 * 1024; w.dst = (bf16_t*)(p.ws + OFF_WOUTA) + (size_t)j * 1024 * 2048; }
    else if (r < 2560) { r -= 2048; w.kind = 2; w.K = 1024; w.N = 2048; w.src = p.in[12] + (size_t)j * 1024 * 2048; w.dst = (bf16_t*)(p.ws + OFF_WINB) + (size_t)j * 2048 * 1024; }
    else if (r < 2816) { r -= 2560; w.kind = 3; w.K = 1024; w.N = 1024; w.src = p.in[21] + (size_t)j * 1024 * 1024; w.dst = (bf16_t*)(p.ws + OFF_WGLU) + (size_t)j * 2048 * 1024; }
    else if (r < 3072) { r -= 2816; w.kind = 4; w.K = 1024; w.N = 1024; w.src = p.in[23] + (size_t)j * 1024 * 1024; w.dst = (bf16_t*)(p.ws + OFF_WGLU) + (size_t)j * 2048 * 1024; }
    else { r -= 3072; w.kind = 5; w.K = 1024; w.N = 1024; w.src = p.in[25] + (size_t)j * 1024 * 1024; w.dst = (bf16_t*)(p.ws + OFF_WOUTB) + (size_t)j * 1024 * 1024; }
    const int ntn = w.N / 64; w.k0 = (r / ntn) * 64; w.n0 = (r % ntn) * 64; return w;
}
__device__ __forceinline__ void convert_weights(const Params& p, float* lt, int t_lo, int t_hi, int wg_lo) {
    if (bidx() < wg_lo) return;
    const int tid = tidx(), stride = gridDim.x - wg_lo; float r[8];
    int tt = t_lo + bidx() - wg_lo;
    if (tt < t_hi) { const WTile w = wtile(p, tt);
#pragma unroll
        for (int i = 0; i < 8; ++i) r[i] = w.src[(size_t)(w.k0 + (tid >> 6) + 8 * i) * w.N + w.n0 + (tid & 63)]; }
    for (; tt < t_hi; tt += stride) {
        const WTile w = wtile(p, tt);
#pragma unroll
        for (int i = 0; i < 8; ++i) lt[((tid >> 6) + 8 * i) * 65 + (tid & 63)] = r[i];
        __syncthreads();
        if (tt + stride < t_hi) { const WTile wn = wtile(p, tt + stride);
#pragma unroll
            for (int i = 0; i < 8; ++i) r[i] = wn.src[(size_t)(wn.k0 + (tid >> 6) + 8 * i) * wn.N + wn.n0 + (tid & 63)]; }
        { const int nn = tid >> 3, k8 = tid & 7; float v[8];
#pragma unroll
          for (int i = 0; i < 8; ++i) v[i] = lt[(k8 * 8 + i) * 65 + nn];
          *(u32x4*)(w.dst + (size_t)nmap(w.kind, w.n0 + nn) * w.K + w.k0 + k8 * 8) = pk8(v); }
        __syncthreads();
    }
}
__device__ __forceinline__ void rownorm_phase(const Params& p, bool first, bool xin_input, const bf16_t* oraw, const float* osq, const float* part, const float* gpost, const float* gpre, bool write_hn) {
    const int lane = tidx() & 63, wv = (bidx() * blockDim.x + tidx()) >> 6, nw = (gridDim.x * blockDim.x) >> 6;
    bf16_t* hn = (bf16_t*)(p.ws + OFF_HN);
    f32x4 gp[4], gq[4];
#pragma unroll
    for (int i = 0; i < 4; ++i) { gp[i] = first ? (f32x4){0.f, 0.f, 0.f, 0.f} : *(const f32x4*)(gpost + i * 256 + lane * 4); gq[i] = *(const f32x4*)(gpre + i * 256 + lane * 4); }
    auto finish = [&](int row, f32x4 (&x)[4]) {
        float* xout = p.out + (size_t)row * D;
        if (!first) {
#pragma unroll
            for (int i = 0; i < 4; ++i) *(f32x4*)(xout + i * 256 + lane * 4) = x[i]; }
        if (write_hn) {
            float q = 0.f;
#pragma unroll
            for (int i = 0; i < 4; ++i) q += x[i][0] * x[i][0] + x[i][1] * x[i][1] + x[i][2] * x[i][2] + x[i][3] * x[i][3];
#pragma unroll
            for (int o = 1; o < 64; o <<= 1) q += shfl_xor_f(q, o);
            const float r2 = rsqrtf(q * (1.f / D) + EPS);
#pragma unroll
            for (int i = 0; i < 4; ++i) { u32x2 w; w.x = pk2(x[i][0] * r2 * gq[i][0], x[i][1] * r2 * gq[i][1]); w.y = pk2(x[i][2] * r2 * gq[i][2], x[i][3] * r2 * gq[i][3]);
                *(u32x2*)(hn + (size_t)row * D + i * 256 + lane * 4) = w; }
        }
    };
    auto load = [&](int row, f32x4 (&x)[4], u32x2 (&w)[4], float& qs) {
        const float* xin = xin_input ? p.in[0] + (size_t)row * D : p.out + (size_t)row * D;
#pragma unroll
        for (int i = 0; i < 4; ++i) x[i] = *(const f32x4*)(xin + i * 256 + lane * 4);
        if (!first) { qs = 0.f;
#pragma unroll
            for (int i = 0; i < 4; ++i) w[i] = *(const u32x2*)(oraw + (size_t)row * D + i * 256 + lane * 4); }
    };
    int row = wv;
    f32x4 xa[4], xb[4]; u32x2 wa[4], wb[4]; float qa = 0.f, qb = 0.f;
    if (row < T_PR) load(row, xa, wa, qa);
    for (; row < T_PR; row += nw) {
        const int nxt = row + nw;
        if (nxt < T_PR) load(nxt, xb, wb, qb);
        if (!first) {
            float qs = 0.f;
#pragma unroll
            for (int i = 0; i < 4; ++i) { const float a0 = bflo(wa[i].x), a1 = bfhi(wa[i].x), a2 = bflo(wa[i].y), a3 = bfhi(wa[i].y); qs += (a0 * a0 + a1 * a1) + (a2 * a2 + a3 * a3); }
#pragma unroll
            for (int o = 1; o < 64; o <<= 1) qs += shfl_xor_f(qs, o);
            const float rs = rsqrtf(qs * (1.f / D) + EPS);
#pragma unroll
            for (int i = 0; i < 4; ++i) { xa[i][0] += bflo(wa[i].x) * rs * gp[i][0]; xa[i][1] += bfhi(wa[i].x) * rs * gp[i][1]; xa[i][2] += bflo(wa[i].y) * rs * gp[i][2]; xa[i][3] += bfhi(wa[i].y) * rs * gp[i][3]; }
        }
        finish(row, xa);
#pragma unroll
        for (int i = 0; i < 4; ++i) { xa[i] = xb[i]; wa[i] = wb[i]; }
        qa = qb;
    }
    if (row < T_ALL) {
        f32x4 x[4];
        const float* xin = xin_input ? p.in[1] + (size_t)(row - T_PR) * D : p.out + (size_t)row * D;
#pragma unroll
        for (int i = 0; i < 4; ++i) x[i] = *(const f32x4*)(xin + i * 256 + lane * 4);
        if (!first) {
            f32x4 o4[4]; float qs = 0.f;
#pragma unroll
            for (int i = 0; i < 4; ++i) { const float* q = part + (size_t)(row - T_PR) * D + i * 256 + lane * 4;
                o4[i] = (*(const f32x4*)q + *(const f32x4*)(q + 512 * D)) + (*(const f32x4*)(q + 2 * 512 * D) + *(const f32x4*)(q + 3 * 512 * D));
                qs += o4[i][0] * o4[i][0] + o4[i][1] * o4[i][1] + o4[i][2] * o4[i][2] + o4[i][3] * o4[i][3]; }
#pragma unroll
            for (int o = 1; o < 64; o <<= 1) qs += shfl_xor_f(qs, o);
            const float rs = rsqrtf(qs * (1.f / D) + EPS);
#pragma unroll
            for (int i = 0; i < 4; ++i) x[i] += o4[i] * rs * gp[i];
        }
        finish(row, x);
    }
}
__device__ __forceinline__ void ssm_tables(const Params& p) {
    const int gt = bidx() * blockDim.x + tidx(), nth = gridDim.x * blockDim.x;
    float* coef = (float*)(p.ws + OFF_COEF); float* tabE = (float*)(p.ws + OFF_TABE);
    for (int it = gt; it < 2 * 64 * 33 * 64; it += nth) {
        const int pp = it & 63, tau = (it >> 6) % 33, jg = it / (64 * 33);
        const float dt = __expf(p.in[15][jg]), ar = p.in[13][jg * 64 + pp], ai = p.in[14][jg * 64 + pp];
        const float mag = expf((float)tau * dt * ar); float sn, cs; sincosf((float)tau * dt * ai, &sn, &cs);
        tabE[(size_t)it * 2] = mag * cs; tabE[(size_t)it * 2 + 1] = mag * sn;
        if (tau == 1) { const float nr = mag * cs - 1.f, ni = mag * sn, den = ar * ar + ai * ai;
            coef[(jg * 64 + pp) * 2] = (nr * ar + ni * ai) / den; coef[(jg * 64 + pp) * 2 + 1] = (ni * ar - nr * ai) / den; }
    }
}
__device__ __forceinline__ void ssm_ktab(const Params& p, float* lt, int u_lo, int u_hi, int wg_lo) {
    if (bidx() < wg_lo) return;
    const int tid = tidx(); float* Ktab = (float*)(p.ws + OFF_KTAB);
    float* F = lt; float* Bs = lt + 512; float* CF = lt + 512 + 2048;
    for (int u = u_lo + bidx() - wg_lo; u < u_hi; u += gridDim.x - wg_lo) {
        const int jg = u >> 3, tau0 = (u & 7) * 4;
        if (tid < 256) { const int tl = tid >> 6, pp = tid & 63, tau = tau0 + tl;
            const float dt = expf(p.in[15][jg]), ar = p.in[13][jg * 64 + pp], ai = p.in[14][jg * 64 + pp];
            float m1 = expf(dt * ar), s1, c1; sincosf(dt * ai, &s1, &c1);
            const float nr = m1 * c1 - 1.f, ni = m1 * s1, den = ar * ar + ai * ai, cr = (nr * ar + ni * ai) / den, ci = (ni * ar - nr * ai) / den;
            float mt = expf((float)tau * dt * ar), st, ct; sincosf((float)tau * dt * ai, &st, &ct);
            const float er = mt * ct, ei = mt * st;
            F[(tl * 64 + pp) * 2] = er * cr - ei * ci; F[(tl * 64 + pp) * 2 + 1] = er * ci + ei * cr; }
#pragma unroll
        for (int i = 0; i < 2; ++i) { const int e = tid + 512 * i;
            Bs[e * 2] = p.in[16][(size_t)jg * 1024 + e]; Bs[e * 2 + 1] = p.in[17][(size_t)jg * 1024 + e]; }
        __syncthreads();
#pragma unroll
        for (int i = 0; i < 8; ++i) { const int e = tid + 512 * i, pp = e & 63, jj = (e >> 6) & 15, tl = e >> 10;
            const float c_r = p.in[18][((size_t)jg * 16 + jj) * 64 + pp], c_i = p.in[19][((size_t)jg * 16 + jj) * 64 + pp], fr_ = F[(tl * 64 + pp) * 2], fi_ = F[(tl * 64 + pp) * 2 + 1];
            CF[e * 2] = c_r * fr_ - c_i * fi_; CF[e * 2 + 1] = c_r * fi_ + c_i * fr_; }
        __syncthreads();
#pragma unroll
        for (int i = 0; i < 2; ++i) { const int e = tid + 512 * i, k = e & 15, jj = (e >> 4) & 15, tl = e >> 8; float acc = 0.f;
            const float* cf = CF + (size_t)(tl * 16 + jj) * 128;
#pragma unroll 8
            for (int pp = 0; pp < 64; ++pp) acc += cf[pp * 2] * Bs[(pp * 16 + k) * 2] - cf[pp * 2 + 1] * Bs[(pp * 16 + k) * 2 + 1];
            if (tau0 + tl == 0 && jj == k) acc += p.in[20][(size_t)jg * 16 + jj];
            Ktab[((size_t)jg * 32 + tau0 + tl) * 256 + jj * 16 + k] = acc; }
        __syncthreads();
    }
}
__device__ __forceinline__ void ws_prep(const Params& p) {
    const int gt = bidx() * blockDim.x + tidx(), nth = gridDim.x * blockDim.x;
    bf16_t* wsb = (bf16_t*)(p.ws + OFF_WSB); float* rs = (float*)(p.ws + OFF_RS);
    for (int it = gt; it < 2 * 8 * 128 * 128; it += nth) { const int s = it & 127, t = (it >> 7) & 127; wsb[it] = f2bf(s <= t ? p.in[9][it] : 0.f); }
    { const int lane = tidx() & 63, wv = gt >> 6, nw = nth >> 6;
      for (int it = wv; it < 2 * 8 * 128; it += nw) { const int t = it & 127;
          float a = (lane <= t ? p.in[9][(size_t)it * 128 + lane] : 0.f) + (64 + lane <= t ? p.in[9][(size_t)it * 128 + 64 + lane] : 0.f);
#pragma unroll
          for (int o = 1; o < 64; o <<= 1) a += shfl_xor_f(a, o);
          if (lane == 0) rs[it] = a; } }
}
__device__ __forceinline__ void ssm_build(const Params& p, int j, int wg_lo) {
    if (bidx() < wg_lo) return;
    const long long gt = (long long)(bidx() - wg_lo) * blockDim.x + tidx(), nth = (long long)(gridDim.x - wg_lo) * blockDim.x;
    const float* Ktab = (const float*)(p.ws + OFF_KTAB) + (size_t)j * 64 * 32 * 256; const float* tabE = (const float*)(p.ws + OFF_TABE) + (size_t)j * 64 * 33 * 64 * 2;
    const float* coef = (const float*)(p.ws + OFF_COEF) + (size_t)j * 64 * 64 * 2;
    bf16_t* TV = (bf16_t*)(p.ws + OFF_TV); bf16_t* WG = (bf16_t*)(p.ws + OFF_WG); bf16_t* XH = (bf16_t*)(p.ws + OFF_XH);
    auto t_item = [&](long long it, u32x4& outv, size_t& off) {
        const int cg8 = (int)(it & 63), rowi = (int)((it >> 6) & 511), g = (int)(it >> 15); const int t = rowi >> 4, jj = rowi & 15, s = cg8 >> 1, k0 = (cg8 & 1) * 8; float v[8];
        if (s <= t) { const float* kp = Ktab + ((size_t)g * 32 + (t - s)) * 256 + jj * 16 + k0; const f32x4 a = *(const f32x4*)kp, b = *(const f32x4*)(kp + 4);
            v[0] = a[0]; v[1] = a[1]; v[2] = a[2]; v[3] = a[3]; v[4] = b[0]; v[5] = b[1]; v[6] = b[2]; v[7] = b[3]; }
        else {
#pragma unroll
            for (int i = 0; i < 8; ++i) v[i] = 0.f; }
        outv = pk8(v); off = ((size_t)g * 512 + rowi) * 640 + cg8 * 8;
    };
    for (long long it = gt; it < 64LL * 512 * 64; it += 4 * nth) {
        u32x4 o4[4]; size_t of[4];
#pragma unroll
        for (int u = 0; u < 4; ++u) if (it + u * nth < 64LL * 512 * 64) t_item(it + u * nth, o4[u], of[u]);
#pragma unroll
        for (int u = 0; u < 4; ++u) if (it + u * nth < 64LL * 512 * 64) *(u32x4*)(TV + of[u]) = o4[u];
    }
    auto v_item = [&](long long it, u32x4& outv, size_t& off) {
        const int q = (int)(it & 15), rowi = (int)((it >> 4) & 511), g = (int)(it >> 13); const int t = rowi >> 4, jj = rowi & 15, im = q >> 3, p0 = (q & 7) * 8; float v[8];
        const float* ep = tabE + (((size_t)g * 33 + t + 1) * 64 + p0) * 2; const f32x4 e0 = *(const f32x4*)ep, e1 = *(const f32x4*)(ep + 4), e2 = *(const f32x4*)(ep + 8), e3 = *(const f32x4*)(ep + 12);
        const float* crp = p.in[18] + (((size_t)j * 64 + g) * 16 + jj) * 64 + p0; const float* cip = p.in[19] + (((size_t)j * 64 + g) * 16 + jj) * 64 + p0;
        const f32x4 cr0 = *(const f32x4*)crp, cr1 = *(const f32x4*)(crp + 4), ci0 = *(const f32x4*)cip, ci1 = *(const f32x4*)(cip + 4);
        const float er[8] = {e0[0], e0[2], e1[0], e1[2], e2[0], e2[2], e3[0], e3[2]}, ei[8] = {e0[1], e0[3], e1[1], e1[3], e2[1], e2[3], e3[1], e3[3]};
        const float c_r[8] = {cr0[0], cr0[1], cr0[2], cr0[3], cr1[0], cr1[1], cr1[2], cr1[3]}, c_i[8] = {ci0[0], ci0[1], ci0[2], ci0[3], ci1[0], ci1[1], ci1[2], ci1[3]};
#pragma unroll
        for (int i = 0; i < 8; ++i) v[i] = im ? -(c_r[i] * ei[i] + c_i[i] * er[i]) : (c_r[i] * er[i] - c_i[i] * ei[i]);
        outv = pk8(v); off = ((size_t)g * 512 + rowi) * 640 + 512 + q * 8;
    };
    for (long long it = gt; it < 64LL * 512 * 16; it += 4 * nth) {
        u32x4 o4[4]; size_t of[4];
#pragma unroll
        for (int u = 0; u < 4; ++u) if (it + u * nth < 64LL * 512 * 16) v_item(it + u * nth, o4[u], of[u]);
#pragma unroll
        for (int u = 0; u < 4; ++u) if (it + u * nth < 64LL * 512 * 16) *(u32x4*)(TV + of[u]) = o4[u];
    }
    auto w_item = [&](long long it, u32x4& outv, size_t& off) {
        const int cg8 = (int)(it & 63), rowi = (int)((it >> 6) & 127), g = (int)(it >> 13); const int im = rowi >> 6, pp = rowi & 63, s = cg8 >> 1, k0 = (cg8 & 1) * 8;
        const float er = tabE[(((size_t)g * 33 + 31 - s) * 64 + pp) * 2], ei = tabE[(((size_t)g * 33 + 31 - s) * 64 + pp) * 2 + 1], cr = coef[(g * 64 + pp) * 2], ci = coef[(g * 64 + pp) * 2 + 1];
        const float fr_ = er * cr - ei * ci, fi_ = er * ci + ei * cr; float v[8];
        const float* brp = p.in[16] + (((size_t)j * 64 + g) * 64 + pp) * 16 + k0; const float* bip = p.in[17] + (((size_t)j * 64 + g) * 64 + pp) * 16 + k0;
        const f32x4 br0 = *(const f32x4*)brp, br1 = *(const f32x4*)(brp + 4), bi0 = *(const f32x4*)bip, bi1 = *(const f32x4*)(bip + 4);
        const float br[8] = {br0[0], br0[1], br0[2], br0[3], br1[0], br1[1], br1[2], br1[3]}, bi[8] = {bi0[0], bi0[1], bi0[2], bi0[3], bi1[0], bi1[1], bi1[2], bi1[3]};
#pragma unroll
        for (int i = 0; i < 8; ++i) v[i] = im ? (fr_ * bi[i] + fi_ * br[i]) : (fr_ * br[i] - fi_ * bi[i]);
        outv = pk8(v); off = ((size_t)g * 128 + rowi) * 512 + cg8 * 8;
    };
    for (long long it = gt; it < 64LL * 128 * 64; it += 4 * nth) {
        u32x4 o4[4]; size_t of[4];
#pragma unroll
        for (int u = 0; u < 4; ++u) if (it + u * nth < 64LL * 128 * 64) w_item(it + u * nth, o4[u], of[u]);
#pragma unroll
        for (int u = 0; u < 4; ++u) if (it + u * nth < 64LL * 128 * 64) *(u32x4*)(WG + of[u]) = o4[u];
    }
}
__device__ __forceinline__ void ssm_mid(const Params& p, int j, LAS unsigned char* lds) {
    const int c = bidx(), tid = tidx(), wid = tid >> 6, lane = tid & 63;
    const float* tabE = (const float*)(p.ws + OFF_TABE) + (size_t)j * 64 * 33 * 64 * 2; const float* S = (const float*)(p.ws + OFF_S); bf16_t* XH = (bf16_t*)(p.ws + OFF_XH);
    if (c < 128) {
        asm volatile("s_waitcnt vmcnt(0)" ::: "memory"); __syncthreads();
        if (tid < 256) { const int g = c >> 1, b = 4 * (c & 1) + wid, pp = lane;
            const float ar = tabE[(((size_t)g * 33 + 32) * 64 + pp) * 2], ai = tabE[(((size_t)g * 33 + 32) * 64 + pp) * 2 + 1];
            float hr = 0.f, hi = 0.f;
            for (int c0 = 0; c0 < 64; c0 += 32) { float sr[32], si[32];
#pragma unroll
                for (int k = 0; k < 32; ++k) { const size_t ch = (size_t)g * NCHK + b * 64 + c0 + k; sr[k] = S[ch * 128 + pp]; si[k] = S[ch * 128 + 64 + pp]; }
#pragma unroll
                for (int k = 0; k < 32; ++k) { const size_t ch = (size_t)g * NCHK + b * 64 + c0 + k;
                    XH[ch * XHW + 512 + pp] = f2bf(hr); XH[ch * XHW + 576 + pp] = f2bf(hi);
                    const float nr = ar * hr - ai * hi + sr[k], ni = ar * hi + ai * hr + si[k]; hr = nr; hi = ni; } }
            p.out[OUT_RP + (((size_t)j * 8 + b) * 64 + g) * 64 + pp] = hr; p.out[OUT_IP + (((size_t)j * 8 + b) * 64 + g) * 64 + pp] = hi; }
    } else {
        const int wb = c - 128, g = wb & 63, jg = j * 64 + g, pp = lane;
        LAS float* Cr = (LAS float*)lds; LAS float* Ci = Cr + 1088; LAS float* Hs = Cr + 2176 + wid * 512;
#pragma unroll
        for (int i = 0; i < 2; ++i) { const int e = tid + 512 * i, jj = e >> 6, q = e & 63;
            Cr[jj * 68 + q] = p.in[18][((size_t)jg * 16 + jj) * 64 + q]; Ci[jj * 68 + q] = p.in[19][((size_t)jg * 16 + jj) * 64 + q]; }
        __syncthreads();
        const float abr = tabE[(((size_t)g * 33 + 1) * 64 + pp) * 2], abi = tabE[(((size_t)g * 33 + 1) * 64 + pp) * 2 + 1];
        const float* coef = (const float*)(p.ws + OFF_COEF) + (size_t)j * 64 * 64 * 2; const float cr = coef[(g * 64 + pp) * 2], ci = coef[(g * 64 + pp) * 2 + 1];
        float Bbr[16], Bbi[16];
#pragma unroll
        for (int k4 = 0; k4 < 4; ++k4) { const f32x4 br = *(const f32x4*)(p.in[16] + ((size_t)jg * 64 + pp) * 16 + k4 * 4), bi = *(const f32x4*)(p.in[17] + ((size_t)jg * 64 + pp) * 16 + k4 * 4);
#pragma unroll
            for (int k = 0; k < 4; ++k) { Bbr[k4 * 4 + k] = cr * br[k] - ci * bi[k]; Bbi[k4 * 4 + k] = cr * bi[k] + ci * br[k]; } }
        const bf16_t* xbs = (const bf16_t*)(p.ws + OFF_XBS); bf16_t* ybuf = (bf16_t*)(p.ws + OFF_HN);
        const int s_l = lane >> 4, j_l = lane & 15; const float dsk = p.in[20][(size_t)jg * 16 + j_l];
        const int b0 = 64 * (wb >> 6) + 8 * wid;
        bf16_t nx = xbs[(size_t)(4 * b0 + s_l) * D + 16 * g + j_l]; float nhr = p.in[2][(((size_t)j * 128 + b0) * 64 + g) * 64 + pp], nhi = p.in[3][(((size_t)j * 128 + b0) * 64 + g) * 64 + pp];
        for (int i = 0; i < 8; ++i) { const int b = b0 + i;
            const float xv = bf2f(nx);
            const size_t si_ = (((size_t)j * 128 + b) * 64 + g) * 64 + pp; float hr = nhr, hi = nhi;
            if (i < 7) { nx = xbs[(size_t)(4 * (b + 1) + s_l) * D + 16 * g + j_l]; nhr = p.in[2][si_ + 4096]; nhi = p.in[3][si_ + 4096]; }
#pragma unroll
            for (int s2 = 0; s2 < 4; ++s2) { float bur = 0.f, bui = 0.f;
#pragma unroll
                for (int k = 0; k < 16; ++k) { const float xs = __int_as_float(__builtin_amdgcn_readlane(__float_as_int(xv), s2 * 16 + k)); bur += Bbr[k] * xs; bui += Bbi[k] * xs; }
                const float nr = abr * hr - abi * hi + bur, ni = abr * hi + abi * hr + bui; hr = nr; hi = ni;
                Hs[s2 * 64 + pp] = hr; Hs[256 + s2 * 64 + pp] = hi; }
            p.out[OUT_RS + si_] = hr; p.out[OUT_IS + si_] = hi;
            asm volatile("s_waitcnt lgkmcnt(0)" ::: "memory");
            float acc = 0.f;
#pragma unroll 4
            for (int q = 0; q < 64; q += 4) { const f32x4 c4r = *(const LAS f32x4*)(Cr + j_l * 68 + q), c4i = *(const LAS f32x4*)(Ci + j_l * 68 + q), h4r = *(const LAS f32x4*)(Hs + s_l * 64 + q), h4i = *(const LAS f32x4*)(Hs + 256 + s_l * 64 + q);
                acc += (c4r[0] * h4r[0] - c4i[0] * h4i[0]) + (c4r[1] * h4r[1] - c4i[1] * h4i[1]) + (c4r[2] * h4r[2] - c4i[2] * h4i[2]) + (c4r[3] * h4r[3] - c4i[3] * h4i[3]); }
            ybuf[(size_t)(T_PR + 4 * b + s_l) * D + 16 * g + j_l] = f2bf(gelu_tanh_f(acc + dsk * xv));
            asm volatile("s_waitcnt lgkmcnt(0)" ::: "memory");
        }
    }
}
__device__ __forceinline__ void load_mu_rstd(const float* vstat, int tok, float& mu, float& rstd) {
    float a = 0.f, q = 0.f;
#pragma unroll
    for (int k = 0; k < 16; ++k) { const float2 w = *(const float2*)(vstat + ((size_t)tok * 16 + k) * 2); a += w.x; q += w.y; }
    mu = a * (1.f / EA); rstd = rsqrtf(q * (1.f / EA) - mu * mu + EPS);
}
__device__ __forceinline__ void vstat_naive(const Params& p) {
    const int gt = bidx() * blockDim.x + tidx(), nth = gridDim.x * blockDim.x;
    const bf16_t* vT = (const bf16_t*)(p.ws + OFF_VT); float* vstat = (float*)(p.ws + OFF_VSTAT);
    for (int tok = gt; tok < T_ALL; tok += nth) { float a = 0.f, q = 0.f;
        for (int c = 0; c < EA; ++c) { const float v = bf2f(vT[(size_t)c * T_ALL + tok]); a += v; q += v * v; }
        for (int k = 0; k < 16; ++k) *(float2*)(vstat + ((size_t)tok * 16 + k) * 2) = k == 0 ? make_float2(a, q) : make_float2(0.f, 0.f); }
}
__device__ __forceinline__ void p2_naive(const Params& p, int j) {
    const long long gt = (long long)bidx() * blockDim.x + tidx(), nth = (long long)gridDim.x * blockDim.x;
    const bf16_t* vT = (const bf16_t*)(p.ws + OFF_VT); bf16_t* uz = (bf16_t*)(p.ws + OFF_UZ); const float* vstat = (const float*)(p.ws + OFF_VSTAT);
    const float* lg = p.in[7] + (size_t)j * EA; const float* lb = p.in[8] + (size_t)j * EA;
    for (long long it = gt; it < (long long)T_ALL * 256; it += nth) {
        const int row = (int)(it % T_ALL), c0 = (int)(it / T_ALL) * 8, h = c0 >> 8; int base, t;
        if (row < T_PR) { base = row & ~127; t = row & 127; } else { const int r = row - T_PR; base = T_PR + (r & ~3); t = r & 3; }
        float acc[8], gg[8], bb[8];
#pragma unroll
        for (int i = 0; i < 8; ++i) { acc[i] = 0.f; gg[i] = lg[c0 + i]; bb[i] = lb[c0 + i]; }
        for (int s = 0; s <= t; ++s) {
            const float w = p.in[9][(((size_t)j * 8 + h) * 128 + t) * 128 + s];
            float mu, rstd; load_mu_rstd(vstat, base + s, mu, rstd);
#pragma unroll
            for (int i = 0; i < 8; ++i) { const float vl = (bf2f(vT[(size_t)(c0 + i) * T_ALL + base + s]) - mu) * rstd * gg[i] + bb[i]; acc[i] += w * vl;
                if (s == t && row >= T_PR) p.out[OUT_CV + ((size_t)j * 512 + (row - T_PR)) * EA + c0 + i] = vl; }
        }
        const float bs = p.in[10][((size_t)j * 8 + h) * 128 + t];
        float u[8], o[8]; bf16_t* up = uz + (size_t)row * EA + c0; unpk8(*(const u32x4*)up, u);
#pragma unroll
        for (int i = 0; i < 8; ++i) o[i] = u[i] * (acc[i] + bs);
        *(u32x4*)up = pk8(o);
    }
}

__device__ __forceinline__ void p2_fast(const Params& p, int j, LAS unsigned char* lds) {
    const int tid = tidx(), wid = tid >> 6, lane = tid & 63, fr = lane & 15, fq = lane >> 4;
    const bf16_t* vT = (const bf16_t*)(p.ws + OFF_VT); bf16_t* uz = (bf16_t*)(p.ws + OFF_UZ); const float* vstat = (const float*)(p.ws + OFF_VSTAT);
    const bf16_t* wsb = (const bf16_t*)(p.ws + OFF_WSB) + (size_t)j * 8 * 128 * 128; const float* rsum = (const float*)(p.ws + OFF_RS) + (size_t)j * 8 * 128;
    const float* lg = p.in[7] + (size_t)j * EA; const float* lb = p.in[8] + (size_t)j * EA; const float* bsp = p.in[10] + (size_t)j * 8 * 128;
    constexpr int PITCH = 272;
    LAS unsigned char* LA = lds; LAS unsigned char* LB = lds + 256 * PITCH;
    LAS float* Lmu = (LAS float*)(lds + 384 * PITCH); LAS float* Lrs = Lmu + 128; LAS float* Lm = Lmu + 256;
    u32x4 vreg[8]; float nmu = 0.f, nrs = 0.f;
    { const int u0 = bidx();
      if (u0 < 1024) { const int chunk = u0 >> 3, h = u0 & 7, tok0 = chunk * 128;
#pragma unroll
        for (int i = 0; i < 8; ++i) { const int idx = tid + 512 * i, row = idx >> 4, c16 = idx & 15; vreg[i] = *(const u32x4*)(vT + (size_t)(h * 256 + row) * T_ALL + tok0 + c16 * 8); }
        if (tid < 128) load_mu_rstd(vstat, tok0 + tid, nmu, nrs); } }
    for (int u = bidx(); u < 1024 + 128; u += gridDim.x) {
        if (u < 1024) {
            const int chunk = u >> 3, h = u & 7, tok0 = chunk * 128;
            if (tid < 128) { Lmu[tid] = nmu; Lrs[tid] = nrs; }
#pragma unroll
            for (int i = 0; i < 8; ++i) { const int idx = tid + 512 * i, row = idx >> 4, c16 = idx & 15; *(LAS u32x4*)(LA + row * PITCH + c16 * 16) = vreg[i]; }
            u32x4 ureg[8], wreg[4];
#pragma unroll
            for (int i = 0; i < 8; ++i) { const int idx = tid + 512 * i, t = idx >> 5, c16 = idx & 31; ureg[i] = *(const u32x4*)(uz + (size_t)(tok0 + t) * EA + h * 256 + c16 * 8); }
#pragma unroll
            for (int i = 0; i < 4; ++i) { const int idx = tid + 512 * i, t = idx >> 4, s0 = (idx & 15) * 8; wreg[i] = *(const u32x4*)(wsb + ((size_t)h * 128 + t) * 128 + s0); }
            __syncthreads();
            { const int un = u + gridDim.x;
              if (un < 1024) { const int chunk2 = un >> 3, h2 = un & 7, tok2 = chunk2 * 128;
#pragma unroll
                for (int i = 0; i < 8; ++i) { const int idx = tid + 512 * i, row = idx >> 4, c16 = idx & 15; vreg[i] = *(const u32x4*)(vT + (size_t)(h2 * 256 + row) * T_ALL + tok2 + c16 * 8); }
                if (tid < 128) load_mu_rstd(vstat, tok2 + tid, nmu, nrs); } }
#pragma unroll
            for (int i = 0; i < 4; ++i) { const int idx = tid + 512 * i, t = idx >> 4, s0 = (idx & 15) * 8;
                float f[8], g8[8]; unpk8(wreg[i], f);
#pragma unroll
                for (int k = 0; k < 8; ++k) f[k] *= Lrs[s0 + k];
                const u32x4 o = pk8(f); unpk8(o, g8); float part = 0.f;
#pragma unroll
                for (int k = 0; k < 8; ++k) part += g8[k] * Lmu[s0 + k];
                *(LAS u32x4*)(LB + t * PITCH + s0 * 2) = o;
                part = red16(part); if ((idx & 15) == 0) Lm[t] = part; }
            __syncthreads();
            f32x4 acc[2][8];
#pragma unroll
            for (int a = 0; a < 2; ++a)
#pragma unroll
                for (int n = 0; n < 8; ++n) acc[a][n] = (f32x4){0.f, 0.f, 0.f, 0.f};
#pragma unroll
            for (int ks = 0; ks < 4; ++ks) {
                const bf16x8 a0 = *(const LAS bf16x8*)(LA + (32 * wid + fr) * PITCH + (ks * 32 + fq * 8) * 2), a1 = *(const LAS bf16x8*)(LA + (32 * wid + 16 + fr) * PITCH + (ks * 32 + fq * 8) * 2);
#pragma unroll
                for (int nf = 0; nf < 8; ++nf) if (ks <= (nf >> 1)) {
                    const bf16x8 bb = *(const LAS bf16x8*)(LB + (16 * nf + fr) * PITCH + (ks * 32 + fq * 8) * 2);
                    acc[0][nf] = __builtin_amdgcn_mfma_f32_16x16x32_bf16(a0, bb, acc[0][nf], 0, 0, 0);
                    acc[1][nf] = __builtin_amdgcn_mfma_f32_16x16x32_bf16(a1, bb, acc[1][nf], 0, 0, 0); }
            }
            __syncthreads();
#pragma unroll
            for (int nf = 0; nf < 8; ++nf) { const int t = 16 * nf + fr; const float mt = Lm[t], rt = rsum[h * 128 + t], bst = bsp[h * 128 + t];
#pragma unroll
                for (int mf = 0; mf < 2; ++mf) { const int cl = 32 * wid + 16 * mf + 4 * fq, C = h * 256 + cl;
                    const f32x4 g4 = *(const f32x4*)(lg + C), b4 = *(const f32x4*)(lb + C); const f32x4 a = acc[mf][nf];
                    u32x2 o; o.x = pk2(g4[0] * (a[0] - mt) + b4[0] * rt + bst, g4[1] * (a[1] - mt) + b4[1] * rt + bst);
                    o.y = pk2(g4[2] * (a[2] - mt) + b4[2] * rt + bst, g4[3] * (a[3] - mt) + b4[3] * rt + bst);
                    *(LAS u32x2*)(LA + t * 528 + cl * 2) = o; } }
            __syncthreads();
#pragma unroll
            for (int i = 0; i < 8; ++i) { const int idx = tidx() + 512 * i, t = idx >> 5, c16 = idx & 31;
                float uu[8], gg[8]; unpk8(ureg[i], uu); unpk8(*(const LAS u32x4*)(LA + t * 528 + c16 * 16), gg);
#pragma unroll
                for (int k = 0; k < 8; ++k) uu[k] *= gg[k];
                *(u32x4*)(uz + (size_t)(tok0 + t) * EA + h * 256 + c16 * 8) = pk8(uu); }
            __syncthreads();
        } else {
            const int b = u - 1024, tokb = T_PR + 4 * b, c0 = tid * 4, h = c0 >> 8;
            float mu[4], rs[4], vl[4][4];
#pragma unroll
            for (int s2 = 0; s2 < 4; ++s2) load_mu_rstd(vstat, tokb + s2, mu[s2], rs[s2]);
            const f32x4 g4 = *(const f32x4*)(lg + c0), b4 = *(const f32x4*)(lb + c0);
#pragma unroll
            for (int cc = 0; cc < 4; ++cc) { const u32x2 w = *(const u32x2*)(vT + (size_t)(c0 + cc) * T_ALL + tokb);
                const float v[4] = {bflo(w.x), bfhi(w.x), bflo(w.y), bfhi(w.y)};
#pragma unroll
                for (int s2 = 0; s2 < 4; ++s2) vl[s2][cc] = (v[s2] - mu[s2]) * rs[s2] * g4[cc] + b4[cc]; }
#pragma unroll
            for (int s2 = 0; s2 < 4; ++s2) *(f32x4*)(p.out + OUT_CV + ((size_t)j * 512 + 4 * b + s2) * EA + c0) = (f32x4){vl[s2][0], vl[s2][1], vl[s2][2], vl[s2][3]};
#pragma unroll
            for (int t = 0; t < 4; ++t) { float sv[4]; const float bst = bsp[h * 128 + t];
#pragma unroll
                for (int cc = 0; cc < 4; ++cc) sv[cc] = bst;
#pragma unroll
                for (int s2 = 0; s2 <= t; ++s2) { const float w = p.in[9][(((size_t)j * 8 + h) * 128 + t) * 128 + s2];
#pragma unroll
                    for (int cc = 0; cc < 4; ++cc) sv[cc] += w * vl[s2][cc]; }
                bf16_t* up = uz + (size_t)(tokb + t) * EA + c0; const u32x2 w = *(const u32x2*)up;
                u32x2 o; o.x = pk2(bflo(w.x) * sv[0], bfhi(w.x) * sv[1]); o.y = pk2(bflo(w.y) * sv[2], bfhi(w.y) * sv[3]); *(u32x2*)up = o; }
        }
    }
}

__global__ void __launch_bounds__(512) mega(Params p) {
    extern __shared__ __attribute__((aligned(16))) unsigned char smem[];
    LAS unsigned char* lds = (LAS unsigned char*)smem;
    if (p.ws == nullptr) cg::this_grid().sync();
    volatile LAS unsigned* xbst = (volatile LAS unsigned*)(lds + STAGE_BYTES);
    if (tidx() == 0) { xbst[0] = 0u; xbst[1] = 0u; xbst[2] = 0u; xbst[3] = 0u; }
    __syncthreads();
    const XcdBarrier xb = xcd_barrier_post((unsigned*)(p.ws + OFF_BAR), xbst);
#define GRID_SYNC() xcd_barrier(xb)
    float* lt = (float*)smem;
    unsigned char* ws = p.ws;
    bf16_t* hn = (bf16_t*)(ws + OFF_HN); float* osq = (float*)(ws + OFF_OSQ); float* vstat = (float*)(ws + OFF_VSTAT);
    {
        if (bidx() & 1) { ssm_ktab(p, lt, 0, 512, 0); convert_weights(p, lt, 0, 3328, 0); } else { convert_weights(p, lt, 0, 3328, 0); ssm_ktab(p, lt, 0, 512, 0); }
        ssm_tables(p);
        ws_prep(p);
        rownorm_phase(p, true, true, nullptr, nullptr, nullptr, nullptr, p.in[4], true);
    }
    GRID_SYNC();
#pragma unroll 1
    for (int j = 0; j < 2; ++j) {
        const int la = 2 * j, lb_ = 2 * j + 1;
        { GemmD g{hn, (const bf16_t*)(ws + OFF_WINA) + (size_t)j * 6144 * 1024, 1024, 1024, 66, 16, 1, 1024, 0, 0};
          EpiUZ e{(bf16_t*)(ws + OFF_UZ)};
          GemmD g2{(const bf16_t*)(ws + OFF_WINA) + (size_t)j * 6144 * 1024 + (size_t)4096 * 1024, hn, 1024, 1024, 8, 66, 1, 1024, 0, 0};
          EpiVT e2; e2.vT = (bf16_t*)(ws + OFF_VT); e2.vstat = vstat;
#if FAST_GEMM
          gemm_fast<EpiUZ, EpiVT, true>(lds, g, e, g2, e2);
          if (j == 0) convert_weights(p, lt, 3328, 3328 + 2048, 48);
#else
          run_gemm<0>(lds, g, e); run_gemm<1>(lds, g2, e2);
#endif
        }
        GRID_SYNC();
#if !FAST_GEMM
        vstat_naive(p); GRID_SYNC();
#endif
#if FAST_P2
        p2_fast(p, j, lds);
#else
        p2_naive(p, j);
#endif
        GRID_SYNC();
        { GemmD g{(const bf16_t*)(ws + OFF_UZ), (const bf16_t*)(ws + OFF_WOUTA) + (size_t)j * 1024 * 2048, 2048, 2048, 64, 4, 1, 2048, 0, 0};
          EpiOut e{(bf16_t*)(ws + OFF_ORA), osq}; run_gemm<2>(lds, g, e);
          GemmD g2{(const bf16_t*)(ws + OFF_UZ) + (size_t)T_PR * 2048, (const bf16_t*)(ws + OFF_WOUTA) + (size_t)j * 1024 * 2048, 2048, 2048, 2, 4, 4, 512, 512, 512};
          EpiPart e2{(float*)(ws + OFF_S)}; run_gemm<2>(lds, g2, e2);
          if (j == 0) ssm_ktab(p, lt, 512, 1024, 32); }
        GRID_SYNC();
        rownorm_phase(p, false, j == 0, (const bf16_t*)(ws + OFF_ORA), osq, (const float*)(ws + OFF_S), p.in[5] + (size_t)la * D, p.in[4] + (size_t)lb_ * D, true);
        GRID_SYNC();
        { GemmD g{hn, (const bf16_t*)(ws + OFF_WINB) + (size_t)j * 2048 * 1024, 1024, 1024, 66, 8, 1, 1024, 0, 0};
          EpiInB e{(bf16_t*)(ws + OFF_XH), (bf16_t*)(ws + OFF_SZ), (bf16_t*)(ws + OFF_XBS)}; run_gemm<3>(lds, g, e);
          ssm_build(p, j, 16); }
        GRID_SYNC();
        { GemmD g{(const bf16_t*)(ws + OFF_XH), (const bf16_t*)(ws + OFF_WG), XHW, 512, 2, 1, 64, 512, (long long)NCHK * XHW, 128LL * 512};
          EpiS1 e{(float*)(ws + OFF_S)}; run_gemm<4>(lds, g, e);
          ssm_mid(p, j, lds); }
        GRID_SYNC();
        { GemmD g{(const bf16_t*)(ws + OFF_XH), (const bf16_t*)(ws + OFF_TV), XHW, 640, 2, 2, 64, 640, (long long)NCHK * XHW, 512LL * 640, 1};
          EpiS3 e{hn}; run_gemm<5>(lds, g, e); }
        GRID_SYNC();
        { GemmD g{hn, (const bf16_t*)(ws + OFF_WGLU) + (size_t)j * 2048 * 1024, 1024, 1024, 66, 8, 1, 1024, 0, 0};
          EpiGlu e{(bf16_t*)(ws + OFF_SZ), p.in[22] + (size_t)j * D, p.in[24] + (size_t)j * D}; run_gemm<6>(lds, g, e);
          if (j == 0) convert_weights(p, lt, 3328 + 2048, 6656, 16); }
        GRID_SYNC();
        { GemmD g{(const bf16_t*)(ws + OFF_SZ), (const bf16_t*)(ws + OFF_WOUTB) + (size_t)j * 1024 * 1024, 1024, 1024, 64, 4, 1, 1024, 0, 0};
          EpiOut e{(bf16_t*)(ws + OFF_ORB), osq}; run_gemm<7>(lds, g, e);
          GemmD g2{(const bf16_t*)(ws + OFF_SZ) + (size_t)T_PR * 1024, (const bf16_t*)(ws + OFF_WOUTB) + (size_t)j * 1024 * 1024, 1024, 1024, 2, 4, 4, 256, 256, 256};
          EpiPart e2{(float*)(ws + OFF_S)}; run_gemm<7>(lds, g2, e2); }
        GRID_SYNC();
        rownorm_phase(p, false, false, (const bf16_t*)(ws + OFF_ORB), osq, (const float*)(ws + OFF_S), p.in[5] + (size_t)lb_ * D, p.in[4] + (size_t)(lb_ + 1 < 4 ? lb_ + 1 : 0) * D, j == 0);
        if (j == 0) GRID_SYNC();
    }
}

extern "C" void kernel_launch(void* const* d_in, const int* in_sizes, int n_in, void* d_out, int out_size, void* d_ws, size_t ws_size, hipStream_t stream) {
    static int grid_blocks = 0;
    constexpr size_t kDynLds = STAGE_BYTES + 64;
    if (!grid_blocks) {
        int dev = 0, cus = 0, per_cu = 0;
        (void)hipGetDevice(&dev);
        (void)hipDeviceGetAttribute(&cus, hipDeviceAttributeMultiprocessorCount, dev);
        (void)hipFuncSetAttribute((const void*)mega, hipFuncAttributeMaxDynamicSharedMemorySize, (int)kDynLds);
        (void)hipOccupancyMaxActiveBlocksPerMultiprocessor(&per_cu, mega, 512, kDynLds);
        if (per_cu < 1) { fprintf(stderr, "occupancy query says %d blocks/CU\n", per_cu); per_cu = 1; }
        grid_blocks = cus;
        if (n_in != 26 || ws_size < 254 * MiB) fprintf(stderr, "unexpected n_in %d / ws_size %zu\n", n_in, ws_size);
    }
    Params p{};
    for (int i = 0; i < 26; ++i) p.in[i] = (const float*)d_in[i];
    p.out = (float*)d_out; p.ws = (unsigned char*)d_ws;
    (void)hipMemsetAsync((unsigned char*)d_ws + OFF_BAR, 0, XCD_BAR_WORDS * sizeof(unsigned), stream);
    void* args[] = {&p};
    hipError_t e = hipLaunchCooperativeKernel((void*)mega, dim3(grid_blocks), dim3(512), args, kDynLds, stream);
    if (e != hipSuccess) fprintf(stderr, "cooperative launch failed: %s (grid %d)\n", hipGetErrorString(e), grid_blocks);
}
```

```cpp
#include <hip/hip_runtime.h>
#include <hip/hip_cooperative_groups.h>
#include <cstdio>
#include <type_traits>
namespace cg = cooperative_groups;

#ifndef FAST_GEMM
#define FAST_GEMM 1
#endif
#ifndef FAST_P2
#define FAST_P2 1
#endif

#define LAS __attribute__((address_space(3)))
typedef unsigned short bf16_t;
typedef short bf16x8 __attribute__((ext_vector_type(8)));
typedef float f32x4 __attribute__((ext_vector_type(4)));
typedef unsigned u32x4 __attribute__((ext_vector_type(4)));
typedef unsigned u32x2 __attribute__((ext_vector_type(2)));

constexpr int T_ALL = 16896, T_PR = 16384, D = 1024, EA = 2048, NCHK = 512, XHW = 640;
constexpr float EPS = 1e-6f;
constexpr size_t MiB = 1u << 20;
constexpr size_t OFF_WINA = 0, OFF_WOUTA = 24 * MiB, OFF_WINB = 32 * MiB, OFF_WGLU = 40 * MiB, OFF_WOUTB = 48 * MiB;
constexpr size_t OFF_SMALL = 52 * MiB;
constexpr size_t OFF_WSB = OFF_SMALL, OFF_RS = OFF_SMALL + 512 * 1024, OFF_VSTAT = 245 * MiB, OFF_OSQ = 248 * MiB, OFF_BAR = 253 * MiB, OFF_XBS = 254 * MiB,
                 OFF_COEF = OFF_SMALL + 896 * 1024, OFF_TABE = OFF_SMALL + 1 * MiB, OFF_KTAB = OFF_SMALL + 4 * MiB;
constexpr size_t OFF_HN = 60 * MiB, OFF_UZ = 93 * MiB, OFF_TV = 93 * MiB, OFF_WG = 133 * MiB, OFF_XH = 141 * MiB, OFF_VT = 159 * MiB,
                 OFF_ORA = 192 * MiB, OFF_SZ = 192 * MiB, OFF_ORB = 141 * MiB, OFF_S = 225 * MiB;
constexpr size_t OUT_CV = 17301504, OUT_RP = 19398656, OUT_IP = 19464192, OUT_RS = 19529728, OUT_IS = 20578304;

struct Params { const float* in[26]; float* out; unsigned char* ws; };

__device__ __forceinline__ int tidx() { int t = threadIdx.x; asm volatile("" : "+v"(t)); return t; }
template <int CTRL> __device__ __forceinline__ float dpp_f(float v) { return __int_as_float(__builtin_amdgcn_update_dpp(0, __float_as_int(v), CTRL, 0xf, 0xf, true)); }
__device__ __forceinline__ float red16(float v) { v += dpp_f<0xB1>(v); v += dpp_f<0x4E>(v); v += dpp_f<0x141>(v); v += dpp_f<0x140>(v); return v; }
__device__ __forceinline__ float shfl_xor_f(float v, int o) { const int l = tidx() & 63; return __int_as_float(__builtin_amdgcn_ds_bpermute((l ^ o) << 2, __float_as_int(v))); }
__device__ __forceinline__ float zero_f() { float z = 0.f; asm volatile("" : "+v"(z)); return z; }
__device__ __forceinline__ int bidx() { int b = blockIdx.x; asm volatile("" : "+s"(b)); return b; }
__device__ __forceinline__ unsigned pk2(float lo, float hi) { unsigned r; asm("v_cvt_pk_bf16_f32 %0, %1, %2" : "=v"(r) : "v"(lo), "v"(hi)); return r; }
__device__ __forceinline__ float bf2f(bf16_t b) { return __uint_as_float(((unsigned)b) << 16); }
__device__ __forceinline__ float bflo(unsigned w) { return __uint_as_float(w << 16); }
__device__ __forceinline__ float bfhi(unsigned w) { return __uint_as_float(w & 0xffff0000u); }
__device__ __forceinline__ bf16_t f2bf(float f) { return (bf16_t)(pk2(f, 0.f) & 0xffffu); }
__device__ __forceinline__ u32x4 pk8(const float (&v)[8]) { u32x4 w; w.x = pk2(v[0], v[1]); w.y = pk2(v[2], v[3]); w.z = pk2(v[4], v[5]); w.w = pk2(v[6], v[7]); return w; }
__device__ __forceinline__ void unpk8(u32x4 w, float (&v)[8]) { v[0] = bflo(w.x); v[1] = bfhi(w.x); v[2] = bflo(w.y); v[3] = bfhi(w.y); v[4] = bflo(w.z); v[5] = bfhi(w.z); v[6] = bflo(w.w); v[7] = bfhi(w.w); }
__device__ __forceinline__ float silu_f(float z) { return z * __builtin_amdgcn_rcpf(1.f + __expf(-z)); }
__device__ __forceinline__ float sigmoid_f(float z) { return __builtin_amdgcn_rcpf(1.f + __expf(-z)); }
__device__ __forceinline__ float gelu_tanh_f(float x) { const float u = 0.7978845608f * (x + 0.044715f * x * x * x); return x * __builtin_amdgcn_rcpf(1.f + __expf(-2.f * u)); }
__device__ __forceinline__ void row2cs(int row, int& chunk, int& s) { if (row < T_PR) { chunk = row >> 5; s = row & 31; } else { const int r = row - T_PR; chunk = 512 + (r >> 2); s = r & 3; } }


#define XB_TMO      128
#define XB_XCNT(j)  (256  + 64 * (j))
#define XB_XSUB(j)  (1280 + 64 * (j))
#define XB_XGEN(j)  (2304 + 64 * (j))
#define XB_TOP      3328
#define XB_TOPGEN   3392
#define XCD_BAR_WORDS 3456
#define XB_SPIN_CAP (1u << 22)
__device__ __forceinline__ unsigned xb_ld(unsigned* p)              { return __hip_atomic_load(p, __ATOMIC_RELAXED, __HIP_MEMORY_SCOPE_AGENT); }
__device__ __forceinline__ unsigned xb_add(unsigned* p, unsigned v) { return __hip_atomic_fetch_add(p, v, __ATOMIC_RELAXED, __HIP_MEMORY_SCOPE_AGENT); }
__device__ __forceinline__ unsigned xb_xcc_id() { return (unsigned)__builtin_amdgcn_s_getreg((3 << 11) | 20) & 0xFu; }
#define XB_SPIN(cond, bar) do { unsigned _sp = 0; while (cond) { __builtin_amdgcn_s_sleep(1); \
    if ((++_sp & 255u) == 0u) { if (xb_ld(&(bar)[XB_TMO])) break; if (_sp > XB_SPIN_CAP) { atomicAdd(&(bar)[XB_TMO], 1u); break; } } } } while (0)
struct XcdBarrier { unsigned* bar; unsigned x; volatile LAS unsigned* st; };
__device__ __forceinline__ XcdBarrier xcd_barrier_post(unsigned* bar, volatile LAS unsigned* st) {
    XcdBarrier b; b.bar = bar; b.x = xb_xcc_id(); b.st = st;
    if (tidx() == 0) (void)xb_add(&bar[XB_XCNT(b.x)], 1u);
    return b;
}
__device__ __forceinline__ void xcd_barrier_complete(unsigned* bar, unsigned x, unsigned& nloc, unsigned& nx) {
    const unsigned G = gridDim.x * gridDim.y * gridDim.z;
    unsigned sum, cnt, mine, sp = 0u;
    for (;;) {
        sum = 0u; cnt = 0u; mine = 0u;
#pragma unroll
        for (unsigned j = 0; j < 16; ++j) { const unsigned c = xb_ld(&bar[XB_XCNT(j)]); sum += c; cnt += (c > 0u) ? 1u : 0u; mine = (j == x) ? c : mine; }
        if (sum == G) break;
        __builtin_amdgcn_s_sleep(1);
        if ((++sp & 255u) == 0u) { if (xb_ld(&bar[XB_TMO])) break; if (sp > XB_SPIN_CAP) { atomicAdd(&bar[XB_TMO], 1u); break; } }
    }
    nloc = mine > 0u ? mine : 1u; nx = cnt > 0u ? cnt : 1u;
}
__device__ __forceinline__ void xcd_barrier(const XcdBarrier& b) {
    asm volatile("s_waitcnt vmcnt(0)" ::: "memory");
    __syncthreads();
    if (tidx() == 0) {
        unsigned* bar = b.bar; unsigned bx = b.x; asm volatile("" : "+s"(bx));
        __builtin_amdgcn_s_waitcnt(0);
        unsigned nloc = b.st[0], nx = b.st[1];
        if (nloc == 0u) { xcd_barrier_complete(bar, bx, nloc, nx); b.st[0] = nloc; b.st[1] = nx; }
        const unsigned old = xb_add(&bar[XB_XSUB(bx)], 1u);
        const unsigned gen = old / nloc;
        if (old + 1u == (gen + 1u) * nloc) {
            __builtin_amdgcn_fence(__ATOMIC_RELEASE, "agent");
            asm volatile("s_waitcnt vmcnt(0)" ::: "memory");
            const unsigned og = xb_add(&bar[XB_TOP], 1u);
            const unsigned tg = og / nx;
            if (og + 1u == (tg + 1u) * nx) xb_add(&bar[XB_TOPGEN], 1u);
            else XB_SPIN(xb_ld(&bar[XB_TOPGEN]) == tg, bar);
            __builtin_amdgcn_fence(__ATOMIC_ACQUIRE, "agent");
            xb_add(&bar[XB_XGEN(bx)], 1u);
            asm volatile("s_waitcnt vmcnt(0)" ::: "memory");
        } else {
            XB_SPIN(xb_ld(&bar[XB_XGEN(bx)]) == gen, bar);
            __builtin_amdgcn_fence(__ATOMIC_ACQUIRE, "agent");
            asm volatile("s_waitcnt vmcnt(0)" ::: "memory");
        }
    }
    __syncthreads();
}

struct GemmD { const bf16_t* A; const bf16_t* Bt; int lda, ldb, nM, nN, nB, K; long long sA, sB; int xr; };

struct EpiUZ {
    bf16_t* uz;
    static constexpr int NPASS = 1;
    __device__ __forceinline__ void begin() {}
    template <bool FAST> __device__ __forceinline__ void row(int, int row, int pn, int c8, const float (&v0)[8], const float (&v1)[8]) {
        float o[8];
#pragma unroll
        for (int i = 0; i < 8; ++i) o[i] = v0[i] * silu_f(v1[i]);
        *(u32x4*)(uz + (size_t)row * EA + 128 * pn + c8) = pk8(o);
    }
    template <bool FAST> __device__ __forceinline__ void end(int, int, int, int) {}
};
struct EpiVT {
    static constexpr int NPASS = 3;
    bf16_t* vT; float* vstat; int pass; float cs[8], cq[8];
    __device__ __forceinline__ void begin() {
#pragma unroll
        for (int i = 0; i < 8; ++i) { cs[i] = 0.f; cq[i] = 0.f; } }
    template <bool FAST> __device__ __forceinline__ void row(int, int row, int pn, int c8, const float (&v0)[8], const float (&v1)[8]) {
        if (!FAST || pass == 0) { *(u32x4*)(vT + (size_t)row * T_ALL + 256 * pn + c8) = pk8(v0); *(u32x4*)(vT + (size_t)row * T_ALL + 256 * pn + 128 + c8) = pk8(v1); return; }
        if (pass == 1) {
#pragma unroll
            for (int i = 0; i < 8; ++i) { cs[i] += v0[i]; cq[i] += v0[i] * v0[i]; asm volatile("" : "+v"(cs[i]), "+v"(cq[i])); } }
        else {
#pragma unroll
            for (int i = 0; i < 8; ++i) { cs[i] += v1[i]; cq[i] += v1[i] * v1[i]; asm volatile("" : "+v"(cs[i]), "+v"(cq[i])); } }
    }
    template <bool FAST> __device__ __forceinline__ void end(int, int pm, int pn, int c8) {
        if (FAST && pass > 0) {
#pragma unroll
            for (int i = 0; i < 8; ++i) {
                cs[i] = red16(cs[i]); cq[i] = red16(cq[i]); }
            if ((tidx() & 15) == 0) { const int slot = pm * 2 + ((tidx() >> 8) & 1);
#pragma unroll
                for (int i = 0; i < 8; ++i) { const int tok = 256 * pn + (pass - 1) * 128 + c8 + i; *(float2*)(vstat + ((size_t)tok * 16 + slot) * 2) = make_float2(cs[i], cq[i]); } }
        }
    }
};
struct EpiOut {
    bf16_t* o; float* osq;
    static constexpr int NPASS = 1;
    __device__ __forceinline__ void begin() {}
    template <bool FAST> __device__ __forceinline__ void row(int, int row, int pn, int c8, const float (&v0)[8], const float (&v1)[8]) {
        *(u32x4*)(o + (size_t)row * D + 256 * pn + c8) = pk8(v0);
        *(u32x4*)(o + (size_t)row * D + 256 * pn + 128 + c8) = pk8(v1);
    }
    template <bool FAST> __device__ __forceinline__ void end(int, int, int, int) {}
};
struct EpiPart {
    static constexpr int NPASS = 1;
    float* P;
    __device__ __forceinline__ void begin() {}
    template <bool FAST> __device__ __forceinline__ void row(int b, int row, int pn, int c8, const float (&v0)[8], const float (&v1)[8]) {
        float* q = P + ((size_t)b * 512 + row) * D + 256 * pn + c8;
        *(f32x4*)q = (f32x4){v0[0], v0[1], v0[2], v0[3]}; *(f32x4*)(q + 4) = (f32x4){v0[4], v0[5], v0[6], v0[7]};
        *(f32x4*)(q + 128) = (f32x4){v1[0], v1[1], v1[2], v1[3]}; *(f32x4*)(q + 132) = (f32x4){v1[4], v1[5], v1[6], v1[7]};
    }
    template <bool FAST> __device__ __forceinline__ void end(int, int, int, int) {}
};
struct EpiInB {
    bf16_t* xh; bf16_t* sz; bf16_t* xbs;
    static constexpr int NPASS = 1;
    __device__ __forceinline__ void begin() {}
    template <bool FAST> __device__ __forceinline__ void row(int, int row, int pn, int c8, const float (&v0)[8], const float (&v1)[8]) {
        if (pn < 4) {
            const int c0 = 256 * pn + c8, c1 = c0 + 128;
            if (row < T_PR) { const int chunk = row >> 5, s = row & 31;
                *(u32x4*)(xh + ((size_t)(c0 >> 4) * NCHK + chunk) * XHW + s * 16 + (c0 & 15)) = pk8(v0);
                *(u32x4*)(xh + ((size_t)(c1 >> 4) * NCHK + chunk) * XHW + s * 16 + (c1 & 15)) = pk8(v1);
            } else { *(u32x4*)(xbs + (size_t)(row - T_PR) * D + c0) = pk8(v0); *(u32x4*)(xbs + (size_t)(row - T_PR) * D + c1) = pk8(v1); }
        } else {
            float a[8], b[8];
#pragma unroll
            for (int i = 0; i < 8; ++i) { a[i] = silu_f(v0[i]); b[i] = silu_f(v1[i]); }
            const int c0 = 256 * (pn - 4) + c8;
            *(u32x4*)(sz + (size_t)row * D + c0) = pk8(a);
            *(u32x4*)(sz + (size_t)row * D + c0 + 128) = pk8(b);
        }
    }
    template <bool FAST> __device__ __forceinline__ void end(int, int, int, int) {}
};
struct EpiS1 {
    float* S;
    static constexpr int NPASS = 1;
    __device__ __forceinline__ void begin() {}
    template <bool FAST> __device__ __forceinline__ void row(int g, int row, int, int c8, const float (&v0)[8], const float (&)[8]) {
        if (row < NCHK) { float* p = S + ((size_t)g * NCHK + row) * 128 + c8; *(f32x4*)p = (f32x4){v0[0], v0[1], v0[2], v0[3]}; *(f32x4*)(p + 4) = (f32x4){v0[4], v0[5], v0[6], v0[7]}; }
    }
    template <bool FAST> __device__ __forceinline__ void end(int, int, int, int) {}
};
struct EpiS3 {
    static constexpr int NPASS = 1;
    bf16_t* y;
    __device__ __forceinline__ void begin() {}
    __device__ __forceinline__ void one(int g, int chunk, int col, const float (&v)[8]) {
        const int t = col >> 4, j0 = col & 15; int tok;
        tok = chunk * 32 + t;
        float o[8];
#pragma unroll
        for (int i = 0; i < 8; ++i) o[i] = gelu_tanh_f(v[i]);
        *(u32x4*)(y + (size_t)tok * D + 16 * g + j0) = pk8(o);
    }
    template <bool FAST> __device__ __forceinline__ void row(int g, int row, int pn, int c8, const float (&v0)[8], const float (&v1)[8]) {
        if (row >= NCHK) return;
        one(g, row, 256 * pn + c8, v0); one(g, row, 256 * pn + 128 + c8, v1);
    }
    template <bool FAST> __device__ __forceinline__ void end(int, int, int, int) {}
};
struct EpiGlu {
    bf16_t* sz; const float* b1; const float* b2;
    static constexpr int NPASS = 1;
    __device__ __forceinline__ void begin() {}
    template <bool FAST> __device__ __forceinline__ void row(int, int row, int pn, int c8, const float (&v0)[8], const float (&v1)[8]) {
        const int c = 128 * pn + c8; bf16_t* p = sz + (size_t)row * D + c;
        float z[8], o[8]; unpk8(*(const u32x4*)p, z);
        const f32x4 p0 = *(const f32x4*)(b1 + c), p1 = *(const f32x4*)(b1 + c + 4), q0 = *(const f32x4*)(b2 + c), q1 = *(const f32x4*)(b2 + c + 4);
        const float bb1[8] = {p0[0], p0[1], p0[2], p0[3], p1[0], p1[1], p1[2], p1[3]}, bb2[8] = {q0[0], q0[1], q0[2], q0[3], q1[0], q1[1], q1[2], q1[3]};
#pragma unroll
        for (int i = 0; i < 8; ++i) o[i] = (v0[i] + bb1[i]) * sigmoid_f(v1[i] + bb2[i]) * z[i];
        *(u32x4*)p = pk8(o);
    }
    template <bool FAST> __device__ __forceinline__ void end(int, int, int, int) {}
    __device__ __forceinline__ void rowz(u32x4 zw, const float (&bb1)[8], const float (&bb2)[8], int row, int pn, int c8, const float (&v0)[8], const float (&v1)[8]) {
        float z[8], o[8]; unpk8(zw, z);
#pragma unroll
        for (int i = 0; i < 8; ++i) o[i] = (v0[i] + bb1[i]) * sigmoid_f(v1[i] + bb2[i]) * z[i];
        *(u32x4*)(sz + (size_t)row * D + 128 * pn + c8) = pk8(o);
    }
};

__device__ __forceinline__ float dot8(const float (&a)[8], u32x4 w) { float b[8]; unpk8(w, b); float s = 0.f;
#pragma unroll
    for (int i = 0; i < 8; ++i) s += a[i] * b[i];
    return s; }
template <class Epi> __device__ void gemm_naive(const GemmD g, Epi E) {
    const long long items = (long long)g.nB * g.nM * g.nN * 4096, nth = (long long)gridDim.x * blockDim.x;
    for (long long it = (long long)bidx() * blockDim.x + tidx(); it < items; it += nth) {
        const int rl = (int)(it & 255), c8 = (int)((it >> 8) & 15) * 8; const long long u = it >> 12;
        const int pm = (int)(u % g.nM); const long long u2 = u / g.nM; const int pn = (int)(u2 % g.nN), b = (int)(u2 / g.nN);
        const int row = pm * 256 + rl;
        const bf16_t* a = g.A + (size_t)b * g.sA + (size_t)row * g.lda;
        const bf16_t* bt = g.Bt + (size_t)b * g.sB + (size_t)(pn * 256 + c8) * g.ldb;
        float v0[8], v1[8];
#pragma unroll
        for (int i = 0; i < 8; ++i) { v0[i] = 0.f; v1[i] = 0.f; }
        for (int k = 0; k < g.K; k += 8) {
            float af[8]; unpk8(*(const u32x4*)(a + k), af);
#pragma unroll
            for (int i = 0; i < 8; ++i) { v0[i] += dot8(af, *(const u32x4*)(bt + (size_t)i * g.ldb + k)); v1[i] += dot8(af, *(const u32x4*)(bt + (size_t)(128 + i) * g.ldb + k)); }
        }
        E.begin(); E.template row<false>(b, row, pn, c8, v0, v1);
    }
}

constexpr int BM = 256, BK = 64, HALF = 128, HTB = HALF * BK * 2, STAGE_BYTES = 8 * HTB, NXCD = 8, WGM = 8;
__device__ __forceinline__ int lds_byte(int r, int c) { const int st = (r >> 4) * 2 + (c >> 5), rr = r & 15, cc = c & 31, ob = rr * 64 + cc * 2; return st * 1024 + (ob ^ (((ob >> 9) & 1) << 5)); }
__device__ __forceinline__ void stage_rc(int b, int& R, int& C) { const int st = b / 1024, sb = b % 1024, swz = sb ^ (((sb >> 9) & 1) << 5); R = (st >> 1) * 16 + swz / 64; C = (st & 1) * 32 + (swz % 64) / 2; }
__device__ __forceinline__ int perm32(int rho) { const int n = rho >> 4, i = rho & 15; return 8 * (i >> 2) + 4 * n + (i & 3); }
struct Unit { int b, pm, pn, w; };
struct Sched {
    int nM, nN, nB, nwg, G, c, n1, nM2, nN2, nwg2, xr;
    __device__ void init(const GemmD& g, const GemmD& g2, bool two, int G_, int c_) { nM = g.nM; nN = g.nN; nB = g.nB; nwg = nM * nN; G = G_; c = c_; n1 = nwg * nB; xr = g.xr;
        nM2 = two ? g2.nM : 0; nN2 = two ? g2.nN : 0; nwg2 = nM2 * nN2; }
    __device__ static void xcdmap(int L, int nM_, int nN_, int nwg_, Unit& u) {
        int wgid = L; { const int q = nwg_ / NXCD, r = nwg_ % NXCD, xcd = wgid % NXCD, off = wgid / NXCD; wgid = (xcd < r ? xcd * (q + 1) : r * (q + 1) + (xcd - r) * q) + off; }
        const int nig = WGM * nN_, gid = wgid / nig, fm = gid * WGM, gsz = (nM_ - fm) < WGM ? (nM_ - fm) : WGM;
        u.b = 0; u.pm = fm + ((wgid % nig) % gsz); u.pn = (wgid % nig) / gsz; }
    __device__ bool next(int i, Unit& u) const {
        const long L = (long)i * G + c; if (L >= (long)n1 + nwg2) return false;
        if (L >= n1) { u.w = 1; xcdmap((int)(L - n1), nM2, nN2, nwg2, u); return true; }
        u.w = 0;
        if (nB == 1) xcdmap((int)L, nM, nN, nwg, u);
        else { const int Lr = xr ? (int)((L & 7) * (n1 >> 3) + (L >> 3)) : (int)L;
            u.b = Lr / nwg; const int r = Lr % nwg; u.pm = r % nM; u.pn = r / nM; }
        return true;
    }
};
template <class Epi, class Epi2, bool TWO>
__device__ __forceinline__ void gemm_fast(LAS unsigned char* lds, const GemmD g, Epi E, const GemmD g2, Epi2 E2) {
    Sched S; S.init(g, g2, TWO, gridDim.x, bidx());
    int tid_ = tidx();
    const int tid = tid_, wid = __builtin_amdgcn_readfirstlane(tid >> 6), lane = tid & 63, wr = wid >> 2, wc = wid & 3, fr = lane & 15, fq = lane >> 4;
    const int K = g.K, nt = K / BK;
    unsigned voffA[2], voffB[2];
#pragma unroll
    for (int i = 0; i < 2; ++i) { int R, C; stage_rc(tid * 16 + i * 8192, R, C); const int Rb = (R & ~31) + perm32(R & 31);
        voffA[i] = (unsigned)(R * g.lda + C) * 2u; voffB[i] = (unsigned)(Rb * g.ldb + C) * 2u; }
    const size_t kstep = (size_t)(BK * 2);
    const size_t hstepA = (size_t)HALF * g.lda * 2, hstepB = (size_t)HALF * g.ldb * 2, tstepA = 2 * hstepA, tstepB = 2 * hstepB;
    const unsigned ldsw = (unsigned)wid * 1024u;
    const int aoff = lds_byte(wr * 64 + fr, fq * 8), boff = lds_byte(wc * 32 + fr, fq * 8);
#define PG8_SA(b, h) (((b) * 2 + (h)) * HTB)
#define PG8_SB(b, h) ((4 + (b) * 2 + (h)) * HTB)
#define PG8_STAGE(bufoff, gbase, voff) do { _Pragma("unroll") for (int _i = 0; _i < 2; ++_i) \
        __builtin_amdgcn_global_load_lds((const unsigned*)((const char*)(gbase) + (voff)[_i]), (LAS unsigned*)(lds + (bufoff) + ldsw + _i * 8192), 16, 0, 0); } while (0)
#define PG8_LDA(dst, b, h) do { _Pragma("unroll") for (int m = 0; m < 4; ++m) _Pragma("unroll") for (int k = 0; k < 2; ++k) dst[m][k] = *(const LAS bf16x8*)(lds + PG8_SA(b, h) + aoff + m * 2048 + k * 1024); } while (0)
#define PG8_LDB(dst, b, h) do { _Pragma("unroll") for (int n = 0; n < 2; ++n) _Pragma("unroll") for (int k = 0; k < 2; ++k) dst[n][k] = *(const LAS bf16x8*)(lds + PG8_SB(b, h) + boff + n * 2048 + k * 1024); } while (0)
#define PG8_MMA(ai, bj, At, Bt) do { __builtin_amdgcn_s_setprio(1); _Pragma("unroll") for (int m = 0; m < 4; ++m) _Pragma("unroll") for (int n = 0; n < 2; ++n) _Pragma("unroll") for (int k = 0; k < 2; ++k) \
        acc[ai][bj][m][n] = __builtin_amdgcn_mfma_f32_16x16x32_bf16(Bt[n][k], At[m][k], acc[ai][bj][m][n], 0, 0, 0); __builtin_amdgcn_s_setprio(0); } while (0)
#define PG8_WAIT_V(n) asm volatile("s_waitcnt vmcnt(" #n ")" ::: "memory")
#define PG8_WAIT_L(n) asm volatile("s_waitcnt lgkmcnt(" #n ")" ::: "memory")
#define PG8_BAR __builtin_amdgcn_s_barrier()
#define PG8_SCHED __builtin_amdgcn_sched_barrier(0)
    Unit cur, nxt; int ui = 0;
    if (!S.next(0, cur)) return;
    f32x4 acc[2][2][4][2];
#pragma unroll
    for (int a = 0; a < 2; ++a)
#pragma unroll
        for (int b = 0; b < 2; ++b)
#pragma unroll
            for (int m = 0; m < 4; ++m)
#pragma unroll
                for (int n = 0; n < 2; ++n) { const float z = zero_f(); acc[a][b][m][n] = (f32x4){z, z, z, z}; }
    bf16x8 At[4][2], B0[2][2], B1[2][2];
    const char* cA = ((TWO && cur.w) ? (const char*)g2.A : (const char*)g.A + (size_t)cur.b * g.sA * 2) + (size_t)cur.pm * tstepA;
    const char* cB = ((TWO && cur.w) ? (const char*)g2.Bt : (const char*)g.Bt + (size_t)cur.b * g.sB * 2) + (size_t)cur.pn * tstepB;
    PG8_STAGE(PG8_SB(0, 0), cB, voffB); PG8_STAGE(PG8_SA(0, 0), cA, voffA); PG8_STAGE(PG8_SB(0, 1), cB + hstepB, voffB); PG8_STAGE(PG8_SA(0, 1), cA + hstepA, voffA);
    if (wr == 1) PG8_BAR;
    PG8_WAIT_V(4); PG8_BAR;
    PG8_STAGE(PG8_SB(1, 0), cB + kstep, voffB); PG8_STAGE(PG8_SA(1, 0), cA + kstep, voffA); PG8_STAGE(PG8_SB(1, 1), cB + hstepB + kstep, voffB);
    PG8_WAIT_V(6); PG8_BAR;
    for (;;) {
        const bool has_next = S.next(ui + 1, nxt);
        const char* nA = has_next ? ((TWO && nxt.w) ? (const char*)g2.A : (const char*)g.A + (size_t)nxt.b * g.sA * 2) + (size_t)nxt.pm * tstepA : cA;
        const char* nB = has_next ? ((TWO && nxt.w) ? (const char*)g2.Bt : (const char*)g.Bt + (size_t)nxt.b * g.sB * 2) + (size_t)nxt.pn * tstepB : cB;
        for (int t = 0; t < nt; t += 2) {
            const bool last = (t == nt - 2);
            const char* a1 = cA + (size_t)(t + 1) * kstep;
            const char* a2 = last ? nA : cA + (size_t)(t + 2) * kstep; const char* b2 = last ? nB : cB + (size_t)(t + 2) * kstep;
            const char* a3 = a2 + kstep; const char* b3 = b2 + kstep;
            PG8_LDB(B0, 0, 0); PG8_SCHED; PG8_LDA(At, 0, 0); PG8_STAGE(PG8_SA(1, 1), a1 + hstepA, voffA);
            PG8_WAIT_L(8); PG8_BAR; PG8_WAIT_L(0); PG8_MMA(0, 0, At, B0); PG8_BAR; PG8_SCHED;
            PG8_LDB(B1, 0, 1); PG8_STAGE(PG8_SB(0, 0), b2, voffB);
            PG8_BAR; PG8_WAIT_L(0); PG8_MMA(0, 1, At, B1); PG8_BAR;
            PG8_LDA(At, 0, 1); PG8_STAGE(PG8_SA(0, 0), a2, voffA);
            PG8_BAR; PG8_WAIT_L(0); PG8_MMA(1, 0, At, B0); PG8_BAR; PG8_SCHED;
            PG8_STAGE(PG8_SB(0, 1), b2 + hstepB, voffB);
            PG8_WAIT_V(6); PG8_BAR; PG8_MMA(1, 1, At, B1); PG8_BAR;
            PG8_LDB(B0, 1, 0); PG8_SCHED; PG8_LDA(At, 1, 0); PG8_STAGE(PG8_SA(0, 1), a2 + hstepA, voffA);
            PG8_WAIT_L(8); PG8_BAR; PG8_WAIT_L(0); PG8_MMA(0, 0, At, B0); PG8_BAR; PG8_SCHED;
            PG8_LDB(B1, 1, 1); PG8_STAGE(PG8_SB(1, 0), b3, voffB);
            PG8_BAR; PG8_WAIT_L(0); PG8_MMA(0, 1, At, B1); PG8_BAR;
            PG8_LDA(At, 1, 1); PG8_STAGE(PG8_SA(1, 0), a3, voffA);
            PG8_BAR; PG8_WAIT_L(0); PG8_MMA(1, 0, At, B0); PG8_BAR; PG8_SCHED;
            PG8_STAGE(PG8_SB(1, 1), b3 + hstepB, voffB);
            PG8_WAIT_V(6); PG8_BAR; PG8_MMA(1, 1, At, B1); PG8_BAR;
        }
        int fr_e = fr, fq_e = fq; asm volatile("" : "+v"(fr_e), "+v"(fq_e));
        auto do_epi = [&](auto& EE) {
            using EpiT = typename std::remove_reference<decltype(EE)>::type;
            if constexpr (std::is_same<EpiT, EpiGlu>::value) {
                u32x4 zr[8]; float bb1[8], bb2[8];
                { const int c = 128 * cur.pn + wc * 32 + fq_e * 8; const f32x4 p0 = *(const f32x4*)(EE.b1 + c), p1 = *(const f32x4*)(EE.b1 + c + 4), q0 = *(const f32x4*)(EE.b2 + c), q1 = *(const f32x4*)(EE.b2 + c + 4);
#pragma unroll
                  for (int i = 0; i < 4; ++i) { bb1[i] = p0[i]; bb1[4 + i] = p1[i]; bb2[i] = q0[i]; bb2[4 + i] = q1[i]; } }
#pragma unroll
                for (int ai = 0; ai < 2; ++ai)
#pragma unroll
                    for (int m = 0; m < 4; ++m) zr[ai * 4 + m] = *(const u32x4*)(EE.sz + (size_t)(cur.pm * BM + ai * HALF + wr * 64 + m * 16 + fr_e) * D + 128 * cur.pn + wc * 32 + fq_e * 8);
#pragma unroll
                for (int ai = 0; ai < 2; ++ai)
#pragma unroll
                    for (int m = 0; m < 4; ++m) {
                        const float v0[8] = {acc[ai][0][m][0][0], acc[ai][0][m][0][1], acc[ai][0][m][0][2], acc[ai][0][m][0][3], acc[ai][0][m][1][0], acc[ai][0][m][1][1], acc[ai][0][m][1][2], acc[ai][0][m][1][3]};
                        const float v1[8] = {acc[ai][1][m][0][0], acc[ai][1][m][0][1], acc[ai][1][m][0][2], acc[ai][1][m][0][3], acc[ai][1][m][1][0], acc[ai][1][m][1][1], acc[ai][1][m][1][2], acc[ai][1][m][1][3]};
                        int fr_i = fr_e, fq_i = fq_e; asm volatile("" : "+v"(fr_i), "+v"(fq_i));
                        EE.rowz(zr[ai * 4 + m], bb1, bb2, cur.pm * BM + ai * HALF + wr * 64 + m * 16 + fr_i, cur.pn, wc * 32 + fq_i * 8, v0, v1);
                        __builtin_amdgcn_sched_barrier(0);
                    }
            } else
            {
#pragma unroll
            for (int pass = 0; pass < EpiT::NPASS; ++pass) {
                if constexpr (EpiT::NPASS > 1) EE.pass = pass;
                EE.begin();
#pragma unroll
                for (int ai = 0; ai < 2; ++ai)
#pragma unroll
                    for (int m = 0; m < 4; ++m) {
                        const float v0[8] = {acc[ai][0][m][0][0], acc[ai][0][m][0][1], acc[ai][0][m][0][2], acc[ai][0][m][0][3], acc[ai][0][m][1][0], acc[ai][0][m][1][1], acc[ai][0][m][1][2], acc[ai][0][m][1][3]};
                        const float v1[8] = {acc[ai][1][m][0][0], acc[ai][1][m][0][1], acc[ai][1][m][0][2], acc[ai][1][m][0][3], acc[ai][1][m][1][0], acc[ai][1][m][1][1], acc[ai][1][m][1][2], acc[ai][1][m][1][3]};
                        int fr_i = fr_e, fq_i = fq_e; asm volatile("" : "+v"(fr_i), "+v"(fq_i));
                        EE.template row<true>(cur.b, cur.pm * BM + ai * HALF + wr * 64 + m * 16 + fr_i, cur.pn, wc * 32 + fq_i * 8, v0, v1);
                        if (m & 1) { asm volatile("" ::: "memory"); __builtin_amdgcn_sched_barrier(0); }
                    }
                EE.template end<true>(cur.b, cur.pm, cur.pn, wc * 32 + fq_e * 8);
            }
            }
        };
        if (TWO && cur.w) do_epi(E2); else do_epi(E);
        if (!has_next) break;
#pragma unroll
        for (int a = 0; a < 2; ++a)
#pragma unroll
            for (int b = 0; b < 2; ++b)
#pragma unroll
                for (int m = 0; m < 4; ++m)
#pragma unroll
                    for (int n = 0; n < 2; ++n) { const float z = zero_f(); acc[a][b][m][n] = (f32x4){z, z, z, z}; }
        cur = nxt; cA = nA; cB = nB; ++ui;
    }
    PG8_WAIT_V(0);
    if (wr == 0) PG8_BAR;
    PG8_BAR;
#undef PG8_SA
#undef PG8_SB
#undef PG8_STAGE
#undef PG8_LDA
#undef PG8_LDB
#undef PG8_MMA
#undef PG8_WAIT_V
#undef PG8_WAIT_L
#undef PG8_BAR
#undef PG8_SCHED
}
#ifndef FMASK
#define FMASK 0xff
#endif
template <int ID, class Epi> __device__ __forceinline__ void run_gemm(LAS unsigned char* lds, const GemmD& g, const Epi& E) {
#if FAST_GEMM
#ifndef PROBE_MASK
#define PROBE_MASK 0
#endif
    for (int r = 0; r < (((PROBE_MASK >> ID) & 1) ? 2 : 1); ++r) { if ((FMASK >> ID) & 1) gemm_fast<Epi, Epi, false>(lds, g, E, g, E); else gemm_naive<Epi>(g, E); }
#else
    gemm_naive<Epi>(g, E);
#endif
}

__device__ __forceinline__ int nmap(int kind, int n) {
    if (kind == 0) { if (n < 2048) return 256 * (n >> 7) + (n & 127); if (n < 4096) return 4096 + (n - 2048); const int c = n - 4096; return 256 * (c >> 7) + 128 + (c & 127); }
    if (kind == 3) return 256 * (n >> 7) + (n & 127);
    if (kind == 4) return 256 * (n >> 7) + 128 + (n & 127);
    return n;
}
struct WTile { const float* src; bf16_t* dst; int kind, K, N, k0, n0; };
__device__ __forceinline__ WTile wtile(const Params& p, int tt) {
    WTile w; const int j = tt / 3328; int r = tt % 3328;
    if (r < 1536) { w.kind = 0; w.K = 1024; w.N = 6144; w.src = p.in[6] + (size_t)j * 1024 * 6144; w.dst = (bf16_t*)(p.ws + OFF_WINA) + (size_t)j * 6144 * 1024; }
    else if (r < 2048) { r -= 1536; w.kind = 1; w.K = 2048; w.N = 1024; w.src = p.in[11] + (size_t)j * 2048 * 1024; w.dst = (bf16_t*)(p.ws + OFF_WOUTA) + (size_t)j * 1024 * 2048; }
    else if (r < 2560) { r -= 2048; w.kind = 2; w.K = 1024; w.N = 2048; w.src = p.in[12] + (size_t)j * 1024 * 2048; w.dst = (bf16_t*)(p.ws + OFF_WINB) + (size_t)j * 2048 * 1024; }
    else if (r < 2816) { r -= 2560; w.kind = 3; w.K = 1024; w.N = 1024; w.src = p.in[21] + (size_t)j * 1024 * 1024; w.dst = (bf16_t*)(p.ws + OFF_WGLU) + (size_t)j * 2048 * 1024; }
    else if (r < 3072) { r -= 2816; w.kind = 4; w.K = 1024; w.N = 1024; w.src = p.in[23] + (size_t)j * 1024 * 1024; w.dst = (bf16_t*)(p.ws + OFF_WGLU) + (size_t)j * 2048 * 1024; }
    else { r -= 3072; w.kind = 5; w.K = 1024; w.N = 1024; w.src = p.in[25] + (size_t)j * 1024 * 1024; w.dst = (bf16_t*)(p.ws + OFF_WOUTB) + (size_t)j * 1024 * 1024; }
    const int ntn = w.N / 64; w.k0 = (r / ntn) * 64; w.n0 = (r % ntn) * 64; return w;
}
__device__ __forceinline__ void convert_weights(const Params& p, float* lt, int t_lo, int t_hi, int wg_lo) {
    if (bidx() < wg_lo) return;
    const int tid = tidx(), stride = gridDim.x - wg_lo; float r[8];
    int tt = t_lo + bidx() - wg_lo;
    if (tt < t_hi) { const WTile w = wtile(p, tt);
#pragma unroll
        for (int i = 0; i < 8; ++i) r[i] = w.src[(size_t)(w.k0 + (tid >> 6) + 8 * i) * w.N + w.n0 + (tid & 63)]; }
    for (; tt < t_hi; tt += stride) {
        const WTile w = wtile(p, tt);
#pragma unroll
        for (int i = 0; i < 8; ++i) lt[((tid >> 6) + 8 * i) * 65 + (tid & 63)] = r[i];
        __syncthreads();
        if (tt + stride < t_hi) { const WTile wn = wtile(p, tt + stride);
#pragma unroll
            for (int i = 0; i < 8; ++i) r[i] = wn.src[(size_t)(wn.k0 + (tid >> 6) + 8 * i) * wn.N + wn.n0 + (tid & 63)]; }
        { const int nn = tid >> 3, k8 = tid & 7; float v[8];
#pragma unroll
          for (int i = 0; i < 8; ++i) v[i] = lt[(k8 * 8 + i) * 65 + nn];
          *(u32x4*)(w.dst + (size_t)nmap(w.kind, w.n0 + nn) * w.K + w.k0 + k8 * 8) = pk8(v); }
        __syncthreads();
    }
}
__device__ __forceinline__ void rownorm_phase(const Params& p, bool first, bool xin_input, const bf16_t* oraw, const float* osq, const float* part, const float* gpost, const float* gpre, bool write_hn) {
    const int lane = tidx() & 63, wv = (bidx() * blockDim.x + tidx()) >> 6, nw = (gridDim.x * blockDim.x) >> 6;
    bf16_t* hn = (bf16_t*)(p.ws + OFF_HN);
    f32x4 gp[4], gq[4];
#pragma unroll
    for (int i = 0; i < 4; ++i) { gp[i] = first ? (f32x4){0.f, 0.f, 0.f, 0.f} : *(const f32x4*)(gpost + i * 256 + lane * 4); gq[i] = *(const f32x4*)(gpre + i * 256 + lane * 4); }
    auto finish = [&](int row, f32x4 (&x)[4]) {
        float* xout = p.out + (size_t)row * D;
        if (!first) {
#pragma unroll
            for (int i = 0; i < 4; ++i) *(f32x4*)(xout + i * 256 + lane * 4) = x[i]; }
        if (write_hn) {
            float q = 0.f;
#pragma unroll
            for (int i = 0; i < 4; ++i) q += x[i][0] * x[i][0] + x[i][1] * x[i][1] + x[i][2] * x[i][2] + x[i][3] * x[i][3];
#pragma unroll
            for (int o = 1; o < 64; o <<= 1) q += shfl_xor_f(q, o);
            const float r2 = rsqrtf(q * (1.f / D) + EPS);
#pragma unroll
            for (int i = 0; i < 4; ++i) { u32x2 w; w.x = pk2(x[i][0] * r2 * gq[i][0], x[i][1] * r2 * gq[i][1]); w.y = pk2(x[i][2] * r2 * gq[i][2], x[i][3] * r2 * gq[i][3]);
                *(u32x2*)(hn + (size_t)row * D + i * 256 + lane * 4) = w; }
        }
    };
    auto load = [&](int row, f32x4 (&x)[4], u32x2 (&w)[4], float& qs) {
        const float* xin = xin_input ? p.in[0] + (size_t)row * D : p.out + (size_t)row * D;
#pragma unroll
        for (int i = 0; i < 4; ++i) x[i] = *(const f32x4*)(xin + i * 256 + lane * 4);
        if (!first) { qs = 0.f;
#pragma unroll
            for (int i = 0; i < 4; ++i) w[i] = *(const u32x2*)(oraw + (size_t)row * D + i * 256 + lane * 4); }
    };
    int row = wv;
    f32x4 xa[4], xb[4]; u32x2 wa[4], wb[4]; float qa = 0.f, qb = 0.f;
    if (row < T_PR) load(row, xa, wa, qa);
    for (; row < T_PR; row += nw) {
        const int nxt = row + nw;
        if (nxt < T_PR) load(nxt, xb, wb, qb);
        if (!first) {
            float qs = 0.f;
#pragma unroll
            for (int i = 0; i < 4; ++i) { const float a0 = bflo(wa[i].x), a1 = bfhi(wa[i].x), a2 = bflo(wa[i].y), a3 = bfhi(wa[i].y); qs += (a0 * a0 + a1 * a1) + (a2 * a2 + a3 * a3); }
#pragma unroll
            for (int o = 1; o < 64; o <<= 1) qs += shfl_xor_f(qs, o);
            const float rs = rsqrtf(qs * (1.f / D) + EPS);
#pragma unroll
            for (int i = 0; i < 4; ++i) { xa[i][0] += bflo(wa[i].x) * rs * gp[i][0]; xa[i][1] += bfhi(wa[i].x) * rs * gp[i][1]; xa[i][2] += bflo(wa[i].y) * rs * gp[i][2]; xa[i][3] += bfhi(wa[i].y) * rs * gp[i][3]; }
        }
        finish(row, xa);
#pragma unroll
        for (int i = 0; i < 4; ++i) { xa[i] = xb[i]; wa[i] = wb[i]; }
        qa = qb;
    }
    if (row < T_ALL) {
        f32x4 x[4];
        const float* xin = xin_input ? p.in[1] + (size_t)(row - T_PR) * D : p.out + (size_t)row * D;
#pragma unroll
        for (int i = 0; i < 4; ++i) x[i] = *(const f32x4*)(xin + i * 256 + lane * 4);
        if (!first) {
            f32x4 o4[4]; float qs = 0.f;
#pragma unroll
            for (int i = 0; i < 4; ++i) { const float* q = part + (size_t)(row - T_PR) * D + i * 256 + lane * 4;
                o4[i] = (*(const f32x4*)q + *(const f32x4*)(q + 512 * D)) + (*(const f32x4*)(q + 2 * 512 * D) + *(const f32x4*)(q + 3 * 512 * D));
                qs += o4[i][0] * o4[i][0] + o4[i][1] * o4[i][1] + o4[i][2] * o4[i][2] + o4[i][3] * o4[i][3]; }
#pragma unroll
            for (int o = 1; o < 64; o <<= 1) qs += shfl_xor_f(qs, o);
            const float rs = rsqrtf(qs * (1.f / D) + EPS);
#pragma unroll
            for (int i = 0; i < 4; ++i) x[i] += o4[i] * rs * gp[i];
        }
        finish(row, x);
    }
}
__device__ __forceinline__ void ssm_tables(const Params& p) {
    const int gt = bidx() * blockDim.x + tidx(), nth = gridDim.x * blockDim.x;
    float* coef = (float*)(p.ws + OFF_COEF); float* tabE = (float*)(p.ws + OFF_TABE);
    for (int it = gt; it < 2 * 64 * 33 * 64; it += nth) {
        const int pp = it & 63, tau = (it >> 6) % 33, jg = it / (64 * 33);
        const float dt = __expf(p.in[15][jg]), ar = p.in[13][jg * 64 + pp], ai = p.in[14][jg * 64 + pp];
        const float mag = expf((float)tau * dt * ar); float sn, cs; sincosf((float)tau * dt * ai, &sn, &cs);
        tabE[(size_t)it * 2] = mag * cs; tabE[(size_t)it * 2 + 1] = mag * sn;
        if (tau == 1) { const float nr = mag * cs - 1.f, ni = mag * sn, den = ar * ar + ai * ai;
            coef[(jg * 64 + pp) * 2] = (nr * ar + ni * ai) / den; coef[(jg * 64 + pp) * 2 + 1] = (ni * ar - nr * ai) / den; }
    }
}
__device__ __forceinline__ void ssm_ktab(const Params& p, float* lt, int u_lo, int u_hi, int wg_lo) {
    if (bidx() < wg_lo) return;
    const int tid = tidx(); float* Ktab = (float*)(p.ws + OFF_KTAB);
    float* F = lt; float* Bs = lt + 512; float* CF = lt + 512 + 2048;
    for (int u = u_lo + bidx() - wg_lo; u < u_hi; u += gridDim.x - wg_lo) {
        const int jg = u >> 3, tau0 = (u & 7) * 4;
        if (tid < 256) { const int tl = tid >> 6, pp = tid & 63, tau = tau0 + tl;
            const float dt = expf(p.in[15][jg]), ar = p.in[13][jg * 64 + pp], ai = p.in[14][jg * 64 + pp];
            float m1 = expf(dt * ar), s1, c1; sincosf(dt * ai, &s1, &c1);
            const float nr = m1 * c1 - 1.f, ni = m1 * s1, den = ar * ar + ai * ai, cr = (nr * ar + ni * ai) / den, ci = (ni * ar - nr * ai) / den;
            float mt = expf((float)tau * dt * ar), st, ct; sincosf((float)tau * dt * ai, &st, &ct);
            const float er = mt * ct, ei = mt * st;
            F[(tl * 64 + pp) * 2] = er * cr - ei * ci; F[(tl * 64 + pp) * 2 + 1] = er * ci + ei * cr; }
#pragma unroll
        for (int i = 0; i < 2; ++i) { const int e = tid + 512 * i;
            Bs[e * 2] = p.in[16][(size_t)jg * 1024 + e]; Bs[e * 2 + 1] = p.in[17][(size_t)jg * 1024 + e]; }
        __syncthreads();
#pragma unroll
        for (int i = 0; i < 8; ++i) { const int e = tid + 512 * i, pp = e & 63, jj = (e >> 6) & 15, tl = e >> 10;
            const float c_r = p.in[18][((size_t)jg * 16 + jj) * 64 + pp], c_i = p.in[19][((size_t)jg * 16 + jj) * 64 + pp], fr_ = F[(tl * 64 + pp) * 2], fi_ = F[(tl * 64 + pp) * 2 + 1];
            CF[e * 2] = c_r * fr_ - c_i * fi_; CF[e * 2 + 1] = c_r * fi_ + c_i * fr_; }
        __syncthreads();
#pragma unroll
        for (int i = 0; i < 2; ++i) { const int e = tid + 512 * i, k = e & 15, jj = (e >> 4) & 15, tl = e >> 8; float acc = 0.f;
            const float* cf = CF + (size_t)(tl * 16 + jj) * 128;
#pragma unroll 8
            for (int pp = 0; pp < 64; ++pp) acc += cf[pp * 2] * Bs[(pp * 16 + k) * 2] - cf[pp * 2 + 1] * Bs[(pp * 16 + k) * 2 + 1];
            if (tau0 + tl == 0 && jj == k) acc += p.in[20][(size_t)jg * 16 + jj];
            Ktab[((size_t)jg * 32 + tau0 + tl) * 256 + jj * 16 + k] = acc; }
        __syncthreads();
    }
}
__device__ __forceinline__ void ws_prep(const Params& p) {
    const int gt = bidx() * blockDim.x + tidx(), nth = gridDim.x * blockDim.x;
    bf16_t* wsb = (bf16_t*)(p.ws + OFF_WSB); float* rs = (float*)(p.ws + OFF_RS);
    for (int it = gt; it < 2 * 8 * 128 * 128; it += nth) { const int s = it & 127, t = (it >> 7) & 127; wsb[it] = f2bf(s <= t ? p.in[9][it] : 0.f); }
    { const int lane = tidx() & 63, wv = gt >> 6, nw = nth >> 6;
      for (int it = wv; it < 2 * 8 * 128; it += nw) { const int t = it & 127;
          float a = (lane <= t ? p.in[9][(size_t)it * 128 + lane] : 0.f) + (64 + lane <= t ? p.in[9][(size_t)it * 128 + 64 + lane] : 0.f);
#pragma unroll
          for (int o = 1; o < 64; o <<= 1) a += shfl_xor_f(a, o);
          if (lane == 0) rs[it] = a; } }
}
__device__ __forceinline__ void ssm_build(const Params& p, int j, int wg_lo) {
    if (bidx() < wg_lo) return;
    const long long gt = (long long)(bidx() - wg_lo) * blockDim.x + tidx(), nth = (long long)(gridDim.x - wg_lo) * blockDim.x;
    const float* Ktab = (const float*)(p.ws + OFF_KTAB) + (size_t)j * 64 * 32 * 256; const float* tabE = (const float*)(p.ws + OFF_TABE) + (size_t)j * 64 * 33 * 64 * 2;
    const float* coef = (const float*)(p.ws + OFF_COEF) + (size_t)j * 64 * 64 * 2;
    bf16_t* TV = (bf16_t*)(p.ws + OFF_TV); bf16_t* WG = (bf16_t*)(p.ws + OFF_WG); bf16_t* XH = (bf16_t*)(p.ws + OFF_XH);
    auto t_item = [&](long long it, u32x4& outv, size_t& off) {
        const int cg8 = (int)(it & 63), rowi = (int)((it >> 6) & 511), g = (int)(it >> 15); const int t = rowi >> 4, jj = rowi & 15, s = cg8 >> 1, k0 = (cg8 & 1) * 8; float v[8];
        if (s <= t) { const float* kp = Ktab + ((size_t)g * 32 + (t - s)) * 256 + jj * 16 + k0; const f32x4 a = *(const f32x4*)kp, b = *(const f32x4*)(kp + 4);
            v[0] = a[0]; v[1] = a[1]; v[2] = a[2]; v[3] = a[3]; v[4] = b[0]; v[5] = b[1]; v[6] = b[2]; v[7] = b[3]; }
        else {
#pragma unroll
            for (int i = 0; i < 8; ++i) v[i] = 0.f; }
        outv = pk8(v); off = ((size_t)g * 512 + rowi) * 640 + cg8 * 8;
    };
    for (long long it = gt; it < 64LL * 512 * 64; it += 4 * nth) {
        u32x4 o4[4]; size_t of[4];
#pragma unroll
        for (int u = 0; u < 4; ++u) if (it + u * nth < 64LL * 512 * 64) t_item(it + u * nth, o4[u], of[u]);
#pragma unroll
        for (int u = 0; u < 4; ++u) if (it + u * nth < 64LL * 512 * 64) *(u32x4*)(TV + of[u]) = o4[u];
    }
    auto v_item = [&](long long it, u32x4& outv, size_t& off) {
        const int q = (int)(it & 15), rowi = (int)((it >> 4) & 511), g = (int)(it >> 13); const int t = rowi >> 4, jj = rowi & 15, im = q >> 3, p0 = (q & 7) * 8; float v[8];
        const float* ep = tabE + (((size_t)g * 33 + t + 1) * 64 + p0) * 2; const f32x4 e0 = *(const f32x4*)ep, e1 = *(const f32x4*)(ep + 4), e2 = *(const f32x4*)(ep + 8), e3 = *(const f32x4*)(ep + 12);
        const float* crp = p.in[18] + (((size_t)j * 64 + g) * 16 + jj) * 64 + p0; const float* cip = p.in[19] + (((size_t)j * 64 + g) * 16 + jj) * 64 + p0;
        const f32x4 cr0 = *(const f32x4*)crp, cr1 = *(const f32x4*)(crp + 4), ci0 = *(const f32x4*)cip, ci1 = *(const f32x4*)(cip + 4);
        const float er[8] = {e0[0], e0[2], e1[0], e1[2], e2[0], e2[2], e3[0], e3[2]}, ei[8] = {e0[1], e0[3], e1[1], e1[3], e2[1], e2[3], e3[1], e3[3]};
        const float c_r[8] = {cr0[0], cr0[1], cr0[2], cr0[3], cr1[0], cr1[1], cr1[2], cr1[3]}, c_i[8] = {ci0[0], ci0[1], ci0[2], ci0[3], ci1[0], ci1[1], ci1[2], ci1[3]};
#pragma unroll
        for (int i = 0; i < 8; ++i) v[i] = im ? -(c_r[i] * ei[i] + c_i[i] * er[i]) : (c_r[i] * er[i] - c_i[i] * ei[i]);
        outv = pk8(v); off = ((size_t)g * 512 + rowi) * 640 + 512 + q * 8;
    };
    for (long long it = gt; it < 64LL * 512 * 16; it += 4 * nth) {
        u32x4 o4[4]; size_t of[4];
#pragma unroll
        for (int u = 0; u < 4; ++u) if (it + u * nth < 64LL * 512 * 16) v_item(it + u * nth, o4[u], of[u]);
#pragma unroll
        for (int u = 0; u < 4; ++u) if (it + u * nth < 64LL * 512 * 16) *(u32x4*)(TV + of[u]) = o4[u];
    }
    auto w_item = [&](long long it, u32x4& outv, size_t& off) {
        const int cg8 = (int)(it & 63), rowi = (int)((it >> 6) & 127), g = (int)(it >> 13); const int im = rowi >> 6, pp = rowi & 63, s = cg8 >> 1, k0 = (cg8 & 1) * 8;
        const float er = tabE[(((size_t)g * 33 + 31 - s) * 64 + pp) * 2], ei = tabE[(((size_t)g * 33 + 31 - s) * 64 + pp) * 2 + 1], cr = coef[(g * 64 + pp) * 2], ci = coef[(g * 64 + pp) * 2 + 1];
        const float fr_ = er * cr - ei * ci, fi_ = er * ci + ei * cr; float v[8];
        const float* brp = p.in[16] + (((size_t)j * 64 + g) * 64 + pp) * 16 + k0; const float* bip = p.in[17] + (((size_t)j * 64 + g) * 64 + pp) * 16 + k0;
        const f32x4 br0 = *(const f32x4*)brp, br1 = *(const f32x4*)(brp + 4), bi0 = *(const f32x4*)bip, bi1 = *(const f32x4*)(bip + 4);
        const float br[8] = {br0[0], br0[1], br0[2], br0[3], br1[0], br1[1], br1[2], br1[3]}, bi[8] = {bi0[0], bi0[1], bi0[2], bi0[3], bi1[0], bi1[1], bi1[2], bi1[3]};
#pragma unroll
        for (int i = 0; i < 8; ++i) v[i] = im ? (fr_ * bi[i] + fi_ * br[i]) : (fr_ * br[i] - fi_ * bi[i]);
        outv = pk8(v); off = ((size_t)g * 128 + rowi) * 512 + cg8 * 8;
    };
    for (long long it = gt; it < 64LL * 128 * 64; it += 4 * nth) {
        u32x4 o4[4]; size_t of[4];
#pragma unroll
        for (int u = 0; u < 4; ++u) if (it + u * nth < 64LL * 128 * 64) w_item(it + u * nth, o4[u], of[u]);
#pragma unroll
        for (int u = 0; u < 4; ++u) if (it + u * nth < 64LL * 128 * 64) *(u32x4*)(WG + of[u]) = o4[u];
    }
}
__device__ __forceinline__ void ssm_mid(const Params& p, int j, LAS unsigned char* lds) {
    const int c = bidx(), tid = tidx(), wid = tid >> 6, lane = tid & 63;
    const float* tabE = (const float*)(p.ws + OFF_TABE) + (size_t)j * 64 * 33 * 64 * 2; const float* S = (const float*)(p.ws + OFF_S); bf16_t* XH = (bf16_t*)(p.ws + OFF_XH);
    if (c < 128) {
        asm volatile("s_waitcnt vmcnt(0)" ::: "memory"); __syncthreads();
        if (tid < 256) { const int g = c >> 1, b = 4 * (c & 1) + wid, pp = lane;
            const float ar = tabE[(((size_t)g * 33 + 32) * 64 + pp) * 2], ai = tabE[(((size_t)g * 33 + 32) * 64 + pp) * 2 + 1];
            float hr = 0.f, hi = 0.f;
            for (int c0 = 0; c0 < 64; c0 += 32) { float sr[32], si[32];
#pragma unroll
                for (int k = 0; k < 32; ++k) { const size_t ch = (size_t)g * NCHK + b * 64 + c0 + k; sr[k] = S[ch * 128 + pp]; si[k] = S[ch * 128 + 64 + pp]; }
#pragma unroll
                for (int k = 0; k < 32; ++k) { const size_t ch = (size_t)g * NCHK + b * 64 + c0 + k;
                    XH[ch * XHW + 512 + pp] = f2bf(hr); XH[ch * XHW + 576 + pp] = f2bf(hi);
                    const float nr = ar * hr - ai * hi + sr[k], ni = ar * hi + ai * hr + si[k]; hr = nr; hi = ni; } }
            p.out[OUT_RP + (((size_t)j * 8 + b) * 64 + g) * 64 + pp] = hr; p.out[OUT_IP + (((size_t)j * 8 + b) * 64 + g) * 64 + pp] = hi; }
    } else {
        const int wb = c - 128, g = wb & 63, jg = j * 64 + g, pp = lane;
        LAS float* Cr = (LAS float*)lds; LAS float* Ci = Cr + 1088; LAS float* Hs = Cr + 2176 + wid * 512;
#pragma unroll
        for (int i = 0; i < 2; ++i) { const int e = tid + 512 * i, jj = e >> 6, q = e & 63;
            Cr[jj * 68 + q] = p.in[18][((size_t)jg * 16 + jj) * 64 + q]; Ci[jj * 68 + q] = p.in[19][((size_t)jg * 16 + jj) * 64 + q]; }
        __syncthreads();
        const float abr = tabE[(((size_t)g * 33 + 1) * 64 + pp) * 2], abi = tabE[(((size_t)g * 33 + 1) * 64 + pp) * 2 + 1];
        const float* coef = (const float*)(p.ws + OFF_COEF) + (size_t)j * 64 * 64 * 2; const float cr = coef[(g * 64 + pp) * 2], ci = coef[(g * 64 + pp) * 2 + 1];
        float Bbr[16], Bbi[16];
#pragma unroll
        for (int k4 = 0; k4 < 4; ++k4) { const f32x4 br = *(const f32x4*)(p.in[16] + ((size_t)jg * 64 + pp) * 16 + k4 * 4), bi = *(const f32x4*)(p.in[17] + ((size_t)jg * 64 + pp) * 16 + k4 * 4);
#pragma unroll
            for (int k = 0; k < 4; ++k) { Bbr[k4 * 4 + k] = cr * br[k] - ci * bi[k]; Bbi[k4 * 4 + k] = cr * bi[k] + ci * br[k]; } }
        const bf16_t* xbs = (const bf16_t*)(p.ws + OFF_XBS); bf16_t* ybuf = (bf16_t*)(p.ws + OFF_HN);
        const int s_l = lane >> 4, j_l = lane & 15; const float dsk = p.in[20][(size_t)jg * 16 + j_l];
        const int b0 = 64 * (wb >> 6) + 8 * wid;
        bf16_t nx = xbs[(size_t)(4 * b0 + s_l) * D + 16 * g + j_l]; float nhr = p.in[2][(((size_t)j * 128 + b0) * 64 + g) * 64 + pp], nhi = p.in[3][(((size_t)j * 128 + b0) * 64 + g) * 64 + pp];
        for (int i = 0; i < 8; ++i) { const int b = b0 + i;
            const float xv = bf2f(nx);
            const size_t si_ = (((size_t)j * 128 + b) * 64 + g) * 64 + pp; float hr = nhr, hi = nhi;
            if (i < 7) { nx = xbs[(size_t)(4 * (b + 1) + s_l) * D + 16 * g + j_l]; nhr = p.in[2][si_ + 4096]; nhi = p.in[3][si_ + 4096]; }
#pragma unroll
            for (int s2 = 0; s2 < 4; ++s2) { float bur = 0.f, bui = 0.f;
#pragma unroll
                for (int k = 0; k < 16; ++k) { const float xs = __int_as_float(__builtin_amdgcn_readlane(__float_as_int(xv), s2 * 16 + k)); bur += Bbr[k] * xs; bui += Bbi[k] * xs; }
                const float nr = abr * hr - abi * hi + bur, ni = abr * hi + abi * hr + bui; hr = nr; hi = ni;
                Hs[s2 * 64 + pp] = hr; Hs[256 + s2 * 64 + pp] = hi; }
            p.out[OUT_RS + si_] = hr; p.out[OUT_IS + si_] = hi;
            asm volatile("s_waitcnt lgkmcnt(0)" ::: "memory");
            float acc = 0.f;
#pragma unroll 4
            for (int q = 0; q < 64; q += 4) { const f32x4 c4r = *(const LAS f32x4*)(Cr + j_l * 68 + q), c4i = *(const LAS f32x4*)(Ci + j_l * 68 + q), h4r = *(const LAS f32x4*)(Hs + s_l * 64 + q), h4i = *(const LAS f32x4*)(Hs + 256 + s_l * 64 + q);
                acc += (c4r[0] * h4r[0] - c4i[0] * h4i[0]) + (c4r[1] * h4r[1] - c4i[1] * h4i[1]) + (c4r[2] * h4r[2] - c4i[2] * h4i[2]) + (c4r[3] * h4r[3] - c4i[3] * h4i[3]); }
            ybuf[(size_t)(T_PR + 4 * b + s_l) * D + 16 * g + j_l] = f2bf(gelu_tanh_f(acc + dsk * xv));
            asm volatile("s_waitcnt lgkmcnt(0)" ::: "memory");
        }
    }
}
__device__ __forceinline__ void load_mu_rstd(const float* vstat, int tok, float& mu, float& rstd) {
    float a = 0.f, q = 0.f;
#pragma unroll
    for (int k = 0; k < 16; ++k) { const float2 w = *(const float2*)(vstat + ((size_t)tok * 16 + k) * 2); a += w.x; q += w.y; }
    mu = a * (1.f / EA); rstd = rsqrtf(q * (1.f / EA) - mu * mu + EPS);
}
__device__ __forceinline__ void vstat_naive(const Params& p) {
    const int gt = bidx() * blockDim.x + tidx(), nth = gridDim.x * blockDim.x;
    const bf16_t* vT = (const bf16_t*)(p.ws + OFF_VT); float* vstat = (float*)(p.ws + OFF_VSTAT);
    for (int tok = gt; tok < T_ALL; tok += nth) { float a = 0.f, q = 0.f;
        for (int c = 0; c < EA; ++c) { const float v = bf2f(vT[(size_t)c * T_ALL + tok]); a += v; q += v * v; }
        for (int k = 0; k < 16; ++k) *(float2*)(vstat + ((size_t)tok * 16 + k) * 2) = k == 0 ? make_float2(a, q) : make_float2(0.f, 0.f); }
}
__device__ __forceinline__ void p2_naive(const Params& p, int j) {
    const long long gt = (long long)bidx() * blockDim.x + tidx(), nth = (long long)gridDim.x * blockDim.x;
    const bf16_t* vT = (const bf16_t*)(p.ws + OFF_VT); bf16_t* uz = (bf16_t*)(p.ws + OFF_UZ); const float* vstat = (const float*)(p.ws + OFF_VSTAT);
    const float* lg = p.in[7] + (size_t)j * EA; const float* lb = p.in[8] + (size_t)j * EA;
    for (long long it = gt; it < (long long)T_ALL * 256; it += nth) {
        const int row = (int)(it % T_ALL), c0 = (int)(it / T_ALL) * 8, h = c0 >> 8; int base, t;
        if (row < T_PR) { base = row & ~127; t = row & 127; } else { const int r = row - T_PR; base = T_PR + (r & ~3); t = r & 3; }
        float acc[8], gg[8], bb[8];
#pragma unroll
        for (int i = 0; i < 8; ++i) { acc[i] = 0.f; gg[i] = lg[c0 + i]; bb[i] = lb[c0 + i]; }
        for (int s = 0; s <= t; ++s) {
            const float w = p.in[9][(((size_t)j * 8 + h) * 128 + t) * 128 + s];
            float mu, rstd; load_mu_rstd(vstat, base + s, mu, rstd);
#pragma unroll
            for (int i = 0; i < 8; ++i) { const float vl = (bf2f(vT[(size_t)(c0 + i) * T_ALL + base + s]) - mu) * rstd * gg[i] + bb[i]; acc[i] += w * vl;
                if (s == t && row >= T_PR) p.out[OUT_CV + ((size_t)j * 512 + (row - T_PR)) * EA + c0 + i] = vl; }
        }
        const float bs = p.in[10][((size_t)j * 8 + h) * 128 + t];
        float u[8], o[8]; bf16_t* up = uz + (size_t)row * EA + c0; unpk8(*(const u32x4*)up, u);
#pragma unroll
        for (int i = 0; i < 8; ++i) o[i] = u[i] * (acc[i] + bs);
        *(u32x4*)up = pk8(o);
    }
}

__device__ __forceinline__ void p2_fast(const Params& p, int j, LAS unsigned char* lds) {
    const int tid = tidx(), wid = tid >> 6, lane = tid & 63, fr = lane & 15, fq = lane >> 4;
    const bf16_t* vT = (const bf16_t*)(p.ws + OFF_VT); bf16_t* uz = (bf16_t*)(p.ws + OFF_UZ); const float* vstat = (const float*)(p.ws + OFF_VSTAT);
    const bf16_t* wsb = (const bf16_t*)(p.ws + OFF_WSB) + (size_t)j * 8 * 128 * 128; const float* rsum = (const float*)(p.ws + OFF_RS) + (size_t)j * 8 * 128;
    const float* lg = p.in[7] + (size_t)j * EA; const float* lb = p.in[8] + (size_t)j * EA; const float* bsp = p.in[10] + (size_t)j * 8 * 128;
    constexpr int PITCH = 272;
    LAS unsigned char* LA = lds; LAS unsigned char* LB = lds + 256 * PITCH;
    LAS float* Lmu = (LAS float*)(lds + 384 * PITCH); LAS float* Lrs = Lmu + 128; LAS float* Lm = Lmu + 256;
    u32x4 vreg[8]; float nmu = 0.f, nrs = 0.f;
    { const int u0 = bidx();
      if (u0 < 1024) { const int chunk = u0 >> 3, h = u0 & 7, tok0 = chunk * 128;
#pragma unroll
        for (int i = 0; i < 8; ++i) { const int idx = tid + 512 * i, row = idx >> 4, c16 = idx & 15; vreg[i] = *(const u32x4*)(vT + (size_t)(h * 256 + row) * T_ALL + tok0 + c16 * 8); }
        if (tid < 128) load_mu_rstd(vstat, tok0 + tid, nmu, nrs); } }
    for (int u = bidx(); u < 1024 + 128; u += gridDim.x) {
        if (u < 1024) {
            const int chunk = u >> 3, h = u & 7, tok0 = chunk * 128;
            if (tid < 128) { Lmu[tid] = nmu; Lrs[tid] = nrs; }
#pragma unroll
            for (int i = 0; i < 8; ++i) { const int idx = tid + 512 * i, row = idx >> 4, c16 = idx & 15; *(LAS u32x4*)(LA + row * PITCH + c16 * 16) = vreg[i]; }
            u32x4 ureg[8], wreg[4];
#pragma unroll
            for (int i = 0; i < 8; ++i) { const int idx = tid + 512 * i, t = idx >> 5, c16 = idx & 31; ureg[i] = *(const u32x4*)(uz + (size_t)(tok0 + t) * EA + h * 256 + c16 * 8); }
#pragma unroll
            for (int i = 0; i < 4; ++i) { const int idx = tid + 512 * i, t = idx >> 4, s0 = (idx & 15) * 8; wreg[i] = *(const u32x4*)(wsb + ((size_t)h * 128 + t) * 128 + s0); }
            __syncthreads();
            { const int un = u + gridDim.x;
              if (un < 1024) { const int chunk2 = un >> 3, h2 = un & 7, tok2 = chunk2 * 128;
#pragma unroll
                for (int i = 0; i < 8; ++i) { const int idx = tid + 512 * i, row = idx >> 4, c16 = idx & 15; vreg[i] = *(const u32x4*)(vT + (size_t)(h2 * 256 + row) * T_ALL + tok2 + c16 * 8); }
                if (tid < 128) load_mu_rstd(vstat, tok2 + tid, nmu, nrs); } }
#pragma unroll
            for (int i = 0; i < 4; ++i) { const int idx = tid + 512 * i, t = idx >> 4, s0 = (idx & 15) * 8;
                float f[8], g8[8]; unpk8(wreg[i], f);
#pragma unroll
                for (int k = 0; k < 8; ++k) f[k] *= Lrs[s0 + k];
                const u32x4 o = pk8(f); unpk8(o, g8); float part = 0.f;
#pragma unroll
                for (int k = 0; k < 8; ++k) part += g8[k] * Lmu[s0 + k];
                *(LAS u32x4*)(LB + t * PITCH + s0 * 2) = o;
                part = red16(part); if ((idx & 15) == 0) Lm[t] = part; }
            __syncthreads();
            f32x4 acc[2][8];
#pragma unroll
            for (int a = 0; a < 2; ++a)
#pragma unroll
                for (int n = 0; n < 8; ++n) acc[a][n] = (f32x4){0.f, 0.f, 0.f, 0.f};
#pragma unroll
            for (int ks = 0; ks < 4; ++ks) {
                const bf16x8 a0 = *(const LAS bf16x8*)(LA + (32 * wid + fr) * PITCH + (ks * 32 + fq * 8) * 2), a1 = *(const LAS bf16x8*)(LA + (32 * wid + 16 + fr) * PITCH + (ks * 32 + fq * 8) * 2);
#pragma unroll
                for (int nf = 0; nf < 8; ++nf) if (ks <= (nf >> 1)) {
                    const bf16x8 bb = *(const LAS bf16x8*)(LB + (16 * nf + fr) * PITCH + (ks * 32 + fq * 8) * 2);
                    acc[0][nf] = __builtin_amdgcn_mfma_f32_16x16x32_bf16(a0, bb, acc[0][nf], 0, 0, 0);
                    acc[1][nf] = __builtin_amdgcn_mfma_f32_16x16x32_bf16(a1, bb, acc[1][nf], 0, 0, 0); }
            }
            __syncthreads();
#pragma unroll
            for (int nf = 0; nf < 8; ++nf) { const int t = 16 * nf + fr; const float mt = Lm[t], rt = rsum[h * 128 + t], bst = bsp[h * 128 + t];
#pragma unroll
                for (int mf = 0; mf < 2; ++mf) { const int cl = 32 * wid + 16 * mf + 4 * fq, C = h * 256 + cl;
                    const f32x4 g4 = *(const f32x4*)(lg + C), b4 = *(const f32x4*)(lb + C); const f32x4 a = acc[mf][nf];
                    u32x2 o; o.x = pk2(g4[0] * (a[0] - mt) + b4[0] * rt + bst, g4[1] * (a[1] - mt) + b4[1] * rt + bst);
                    o.y = pk2(g4[2] * (a[2] - mt) + b4[2] * rt + bst, g4[3] * (a[3] - mt) + b4[3] * rt + bst);
                    *(LAS u32x2*)(LA + t * 528 + cl * 2) = o; } }
            __syncthreads();
#pragma unroll
            for (int i = 0; i < 8; ++i) { const int idx = tidx() + 512 * i, t = idx >> 5, c16 = idx & 31;
                float uu[8], gg[8]; unpk8(ureg[i], uu); unpk8(*(const LAS u32x4*)(LA + t * 528 + c16 * 16), gg);
#pragma unroll
                for (int k = 0; k < 8; ++k) uu[k] *= gg[k];
                *(u32x4*)(uz + (size_t)(tok0 + t) * EA + h * 256 + c16 * 8) = pk8(uu); }
            __syncthreads();
        } else {
            const int b = u - 1024, tokb = T_PR + 4 * b, c0 = tid * 4, h = c0 >> 8;
            float mu[4], rs[4], vl[4][4];
#pragma unroll
            for (int s2 = 0; s2 < 4; ++s2) load_mu_rstd(vstat, tokb + s2, mu[s2], rs[s2]);
            const f32x4 g4 = *(const f32x4*)(lg + c0), b4 = *(const f32x4*)(lb + c0);
#pragma unroll
            for (int cc = 0; cc < 4; ++cc) { const u32x2 w = *(const u32x2*)(vT + (size_t)(c0 + cc) * T_ALL + tokb);
                const float v[4] = {bflo(w.x), bfhi(w.x), bflo(w.y), bfhi(w.y)};
#pragma unroll
                for (int s2 = 0; s2 < 4; ++s2) vl[s2][cc] = (v[s2] - mu[s2]) * rs[s2] * g4[cc] + b4[cc]; }
#pragma unroll
            for (int s2 = 0; s2 < 4; ++s2) *(f32x4*)(p.out + OUT_CV + ((size_t)j * 512 + 4 * b + s2) * EA + c0) = (f32x4){vl[s2][0], vl[s2][1], vl[s2][2], vl[s2][3]};
#pragma unroll
            for (int t = 0; t < 4; ++t) { float sv[4]; const float bst = bsp[h * 128 + t];
#pragma unroll
                for (int cc = 0; cc < 4; ++cc) sv[cc] = bst;
#pragma unroll
                for (int s2 = 0; s2 <= t; ++s2) { const float w = p.in[9][(((size_t)j * 8 + h) * 128 + t) * 128 + s2];
#pragma unroll
                    for (int cc = 0; cc < 4; ++cc) sv[cc] += w * vl[s2][cc]; }
                bf16_t* up = uz + (size_t)(tokb + t) * EA + c0; const u32x2 w = *(const u32x2*)up;
                u32x2 o; o.x = pk2(bflo(w.x) * sv[0], bfhi(w.x) * sv[1]); o.y = pk2(bflo(w.y) * sv[2], bfhi(w.y) * sv[3]); *(u32x2*)up = o; }
        }
    }
}

__global__ void __launch_bounds__(512) mega(Params p) {
    extern __shared__ __attribute__((aligned(16))) unsigned char smem[];
    LAS unsigned char* lds = (LAS unsigned char*)smem;
    if (p.ws == nullptr) cg::this_grid().sync();
    volatile LAS unsigned* xbst = (volatile LAS unsigned*)(lds + STAGE_BYTES);
    if (tidx() == 0) { xbst[0] = 0u; xbst[1] = 0u; xbst[2] = 0u; xbst[3] = 0u; }
    __syncthreads();
    const XcdBarrier xb = xcd_barrier_post((unsigned*)(p.ws + OFF_BAR), xbst);
#define GRID_SYNC() xcd_barrier(xb)
    float* lt = (float*)smem;
    unsigned char* ws = p.ws;
    bf16_t* hn = (bf16_t*)(ws + OFF_HN); float* osq = (float*)(ws + OFF_OSQ); float* vstat = (float*)(ws + OFF_VSTAT);
    {
        if (bidx() & 1) { ssm_ktab(p, lt, 0, 512, 0); convert_weights(p, lt, 0, 1536, 0); } else { convert_weights(p, lt, 0, 1536, 0); ssm_ktab(p, lt, 0, 512, 0); }
        ssm_tables(p);
        ws_prep(p);
        rownorm_phase(p, true, true, nullptr, nullptr, nullptr, nullptr, p.in[4], true);
    }
    GRID_SYNC();
#pragma unroll 1
    for (int j = 0; j < 2; ++j) {
        const int la = 2 * j, lb_ = 2 * j + 1;
        { GemmD g{hn, (const bf16_t*)(ws + OFF_WINA) + (size_t)j * 6144 * 1024, 1024, 1024, 66, 16, 1, 1024, 0, 0};
          EpiUZ e{(bf16_t*)(ws + OFF_UZ)};
          GemmD g2{(const bf16_t*)(ws + OFF_WINA) + (size_t)j * 6144 * 1024 + (size_t)4096 * 1024, hn, 1024, 1024, 8, 66, 1, 1024, 0, 0};
          EpiVT e2; e2.vT = (bf16_t*)(ws + OFF_VT); e2.vstat = vstat;
#if FAST_GEMM
          gemm_fast<EpiUZ, EpiVT, true>(lds, g, e, g2, e2);
          if (j == 0) convert_weights(p, lt, 1536, 3328, 48);
#else
          run_gemm<0>(lds, g, e); run_gemm<1>(lds, g2, e2);
#endif
        }
        GRID_SYNC();
#if !FAST_GEMM
        vstat_naive(p); GRID_SYNC();
#endif
#if FAST_P2
        p2_fast(p, j, lds);
#else
        p2_naive(p, j);
#endif
        GRID_SYNC();
        { GemmD g{(const bf16_t*)(ws + OFF_UZ), (const bf16_t*)(ws + OFF_WOUTA) + (size_t)j * 1024 * 2048, 2048, 2048, 64, 4, 1, 2048, 0, 0};
          EpiOut e{(bf16_t*)(ws + OFF_ORA), osq}; run_gemm<2>(lds, g, e);
          GemmD g2{(const bf16_t*)(ws + OFF_UZ) + (size_t)T_PR * 2048, (const bf16_t*)(ws + OFF_WOUTA) + (size_t)j * 1024 * 2048, 2048, 2048, 2, 4, 4, 512, 512, 512};
          EpiPart e2{(float*)(ws + OFF_S)}; run_gemm<2>(lds, g2, e2);
          if (j == 0) ssm_ktab(p, lt, 512, 1024, 32); }
        GRID_SYNC();
        rownorm_phase(p, false, j == 0, (const bf16_t*)(ws + OFF_ORA), osq, (const float*)(ws + OFF_S), p.in[5] + (size_t)la * D, p.in[4] + (size_t)lb_ * D, true);
        GRID_SYNC();
        { GemmD g{hn, (const bf16_t*)(ws + OFF_WINB) + (size_t)j * 2048 * 1024, 1024, 1024, 66, 8, 1, 1024, 0, 0};
          EpiInB e{(bf16_t*)(ws + OFF_XH), (bf16_t*)(ws + OFF_SZ), (bf16_t*)(ws + OFF_XBS)}; run_gemm<3>(lds, g, e);
          ssm_build(p, j, 16); }
        GRID_SYNC();
        { GemmD g{(const bf16_t*)(ws + OFF_XH), (const bf16_t*)(ws + OFF_WG), XHW, 512, 2, 1, 64, 512, (long long)NCHK * XHW, 128LL * 512};
          EpiS1 e{(float*)(ws + OFF_S)}; run_gemm<4>(lds, g, e);
          ssm_mid(p, j, lds); }
        GRID_SYNC();
        { GemmD g{(const bf16_t*)(ws + OFF_XH), (const bf16_t*)(ws + OFF_TV), XHW, 640, 2, 2, 64, 640, (long long)NCHK * XHW, 512LL * 640, 1};
          EpiS3 e{hn}; run_gemm<5>(lds, g, e); }
        GRID_SYNC();
        { GemmD g{hn, (const bf16_t*)(ws + OFF_WGLU) + (size_t)j * 2048 * 1024, 1024, 1024, 66, 8, 1, 1024, 0, 0};
          EpiGlu e{(bf16_t*)(ws + OFF_SZ), p.in[22] + (size_t)j * D, p.in[24] + (size_t)j * D}; run_gemm<6>(lds, g, e);
          if (j == 0) { convert_weights(p, lt, 3328, 3328 + 1536, 16); convert_weights(p, lt, 3328 + 2048, 6656, 16); } }
        GRID_SYNC();
        { GemmD g{(const bf16_t*)(ws + OFF_SZ), (const bf16_t*)(ws + OFF_WOUTB) + (size_t)j * 1024 * 1024, 1024, 1024, 64, 4, 1, 1024, 0, 0};
          EpiOut e{(bf16_t*)(ws + OFF_ORB), osq}; run_gemm<7>(lds, g, e);
          GemmD g2{(const bf16_t*)(ws + OFF_SZ) + (size_t)T_PR * 1024, (const bf16_t*)(ws + OFF_WOUTB) + (size_t)j * 1024 * 1024, 1024, 1024, 2, 4, 4, 256, 256, 256};
          EpiPart e2{(float*)(ws + OFF_S)}; run_gemm<7>(lds, g2, e2);
          if (j == 0) convert_weights(p, lt, 3328 + 1536, 3328 + 2048, 32); }
        GRID_SYNC();
        rownorm_phase(p, false, false, (const bf16_t*)(ws + OFF_ORB), osq, (const float*)(ws + OFF_S), p.in[5] + (size_t)lb_ * D, p.in[4] + (size_t)(lb_ + 1 < 4 ? lb_ + 1 : 0) * D, j == 0);
        if (j == 0) GRID_SYNC();
    }
}

extern "C" void kernel_launch(void* const* d_in, const int* in_sizes, int n_in, void* d_out, int out_size, void* d_ws, size_t ws_size, hipStream_t stream) {
    static int grid_blocks = 0;
    constexpr size_t kDynLds = STAGE_BYTES + 64;
    if (!grid_blocks) {
        int dev = 0, cus = 0, per_cu = 0;
        (void)hipGetDevice(&dev);
        (void)hipDeviceGetAttribute(&cus, hipDeviceAttributeMultiprocessorCount, dev);
        (void)hipFuncSetAttribute((const void*)mega, hipFuncAttributeMaxDynamicSharedMemorySize, (int)kDynLds);
        (void)hipOccupancyMaxActiveBlocksPerMultiprocessor(&per_cu, mega, 512, kDynLds);
        if (per_cu < 1) { fprintf(stderr, "occupancy query says %d blocks/CU\n", per_cu); per_cu = 1; }
        grid_blocks = cus;
        if (n_in != 26 || ws_size < 254 * MiB) fprintf(stderr, "unexpected n_in %d / ws_size %zu\n", n_in, ws_size);
    }
    Params p{};
    for (int i = 0; i < 26; ++i) p.in[i] = (const float*)d_in[i];
    p.out = (float*)d_out; p.ws = (unsigned char*)d_ws;
    (void)hipMemsetAsync((unsigned char*)d_ws + OFF_BAR, 0, XCD_BAR_WORDS * sizeof(unsigned), stream);
    void* args[] = {&p};
    hipError_t e = hipLaunchCooperativeKernel((void*)mega, dim3(grid_blocks), dim3(512), args, kDynLds, stream);
    if (e != hipSuccess) fprintf(stderr, "cooperative launch failed: %s (grid %d)\n", hipGetErrorString(e), grid_blocks);
}
```

```cpp
#include <hip/hip_runtime.h>
#include <hip/hip_cooperative_groups.h>
#include <cstdio>
#include <type_traits>
namespace cg = cooperative_groups;

#ifndef FAST_GEMM
#define FAST_GEMM 1
#endif
#ifndef FAST_P2
#define FAST_P2 1
#endif

#define LAS __attribute__((address_space(3)))
typedef unsigned short bf16_t;
typedef short bf16x8 __attribute__((ext_vector_type(8)));
typedef float f32x4 __attribute__((ext_vector_type(4)));
typedef unsigned u32x4 __attribute__((ext_vector_type(4)));
typedef unsigned u32x2 __attribute__((ext_vector_type(2)));

constexpr int T_ALL = 16896, T_PR = 16384, D = 1024, EA = 2048, NCHK = 512, XHW = 640;
constexpr float EPS = 1e-6f;
constexpr size_t MiB = 1u << 20;
constexpr size_t OFF_WINA = 0, OFF_WOUTA = 24 * MiB, OFF_WINB = 32 * MiB, OFF_WGLU = 40 * MiB, OFF_WOUTB = 48 * MiB;
constexpr size_t OFF_SMALL = 52 * MiB;
constexpr size_t OFF_WSB = OFF_SMALL, OFF_RS = OFF_SMALL + 512 * 1024, OFF_VSTAT = 245 * MiB, OFF_OSQ = 248 * MiB, OFF_BAR = 253 * MiB, OFF_XBS = 254 * MiB,
                 OFF_COEF = OFF_SMALL + 896 * 1024, OFF_TABE = OFF_SMALL + 1 * MiB, OFF_KTAB = OFF_SMALL + 4 * MiB;
constexpr size_t OFF_HN = 60 * MiB, OFF_UZ = 93 * MiB, OFF_TV = 93 * MiB, OFF_WG = 133 * MiB, OFF_XH = 141 * MiB, OFF_VT = 159 * MiB,
                 OFF_ORA = 192 * MiB, OFF_SZ = 192 * MiB, OFF_ORB = 141 * MiB, OFF_S = 225 * MiB;
constexpr size_t OUT_CV = 17301504, OUT_RP = 19398656, OUT_IP = 19464192, OUT_RS = 19529728, OUT_IS = 20578304;

struct Params { const float* in[26]; float* out; unsigned char* ws; };

__device__ __forceinline__ int tidx() { int t = threadIdx.x; asm volatile("" : "+v"(t)); return t; }
template <int CTRL> __device__ __forceinline__ float dpp_f(float v) { return __int_as_float(__builtin_amdgcn_update_dpp(0, __float_as_int(v), CTRL, 0xf, 0xf, true)); }
__device__ __forceinline__ float red16(float v) { v += dpp_f<0xB1>(v); v += dpp_f<0x4E>(v); v += dpp_f<0x141>(v); v += dpp_f<0x140>(v); return v; }
__device__ __forceinline__ float shfl_xor_f(float v, int o) { const int l = tidx() & 63; return __int_as_float(__builtin_amdgcn_ds_bpermute((l ^ o) << 2, __float_as_int(v))); }
__device__ __forceinline__ float zero_f() { float z = 0.f; asm volatile("" : "+v"(z)); return z; }
__device__ __forceinline__ int bidx() { int b = blockIdx.x; asm volatile("" : "+s"(b)); return b; }
__device__ __forceinline__ unsigned pk2(float lo, float hi) { unsigned r; asm("v_cvt_pk_bf16_f32 %0, %1, %2" : "=v"(r) : "v"(lo), "v"(hi)); return r; }
__device__ __forceinline__ float bf2f(bf16_t b) { return __uint_as_float(((unsigned)b) << 16); }
__device__ __forceinline__ float bflo(unsigned w) { return __uint_as_float(w << 16); }
__device__ __forceinline__ float bfhi(unsigned w) { return __uint_as_float(w & 0xffff0000u); }
__device__ __forceinline__ bf16_t f2bf(float f) { return (bf16_t)(pk2(f, 0.f) & 0xffffu); }
__device__ __forceinline__ u32x4 pk8(const float (&v)[8]) { u32x4 w; w.x = pk2(v[0], v[1]); w.y = pk2(v[2], v[3]); w.z = pk2(v[4], v[5]); w.w = pk2(v[6], v[7]); return w; }
__device__ __forceinline__ void unpk8(u32x4 w, float (&v)[8]) { v[0] = bflo(w.x); v[1] = bfhi(w.x); v[2] = bflo(w.y); v[3] = bfhi(w.y); v[4] = bflo(w.z); v[5] = bfhi(w.z); v[6] = bflo(w.w); v[7] = bfhi(w.w); }
__device__ __forceinline__ float silu_f(float z) { return z * __builtin_amdgcn_rcpf(1.f + __expf(-z)); }
__device__ __forceinline__ float sigmoid_f(float z) { return __builtin_amdgcn_rcpf(1.f + __expf(-z)); }
__device__ __forceinline__ float gelu_tanh_f(float x) { const float u = 0.7978845608f * (x + 0.044715f * x * x * x); return x * __builtin_amdgcn_rcpf(1.f + __expf(-2.f * u)); }
__device__ __forceinline__ void row2cs(int row, int& chunk, int& s) { if (row < T_PR) { chunk = row >> 5; s = row & 31; } else { const int r = row - T_PR; chunk = 512 + (r >> 2); s = r & 3; } }


#define XB_TMO      128
#define XB_XCNT(j)  (256  + 64 * (j))
#define XB_XSUB(j)  (1280 + 64 * (j))
#define XB_XGEN(j)  (2304 + 64 * (j))
#define XB_TOP      3328
#define XB_TOPGEN   3392
#define XCD_BAR_WORDS 3456
#define XB_SPIN_CAP (1u << 22)
__device__ __forceinline__ unsigned xb_ld(unsigned* p)              { return __hip_atomic_load(p, __ATOMIC_RELAXED, __HIP_MEMORY_SCOPE_AGENT); }
__device__ __forceinline__ unsigned xb_add(unsigned* p, unsigned v) { return __hip_atomic_fetch_add(p, v, __ATOMIC_RELAXED, __HIP_MEMORY_SCOPE_AGENT); }
__device__ __forceinline__ unsigned xb_xcc_id() { return (unsigned)__builtin_amdgcn_s_getreg((3 << 11) | 20) & 0xFu; }
#define XB_SPIN(cond, bar) do { unsigned _sp = 0; while (cond) { __builtin_amdgcn_s_sleep(1); \
    if ((++_sp & 255u) == 0u) { if (xb_ld(&(bar)[XB_TMO])) break; if (_sp > XB_SPIN_CAP) { atomicAdd(&(bar)[XB_TMO], 1u); break; } } } } while (0)
struct XcdBarrier { unsigned* bar; unsigned x; volatile LAS unsigned* st; };
__device__ __forceinline__ XcdBarrier xcd_barrier_post(unsigned* bar, volatile LAS unsigned* st) {
    XcdBarrier b; b.bar = bar; b.x = xb_xcc_id(); b.st = st;
    if (tidx() == 0) (void)xb_add(&bar[XB_XCNT(b.x)], 1u);
    return b;
}
__device__ __forceinline__ void xcd_barrier_complete(unsigned* bar, unsigned x, unsigned& nloc, unsigned& nx) {
    const unsigned G = gridDim.x * gridDim.y * gridDim.z;
    unsigned sum, cnt, mine, sp = 0u;
    for (;;) {
        sum = 0u; cnt = 0u; mine = 0u;
#pragma unroll
        for (unsigned j = 0; j < 16; ++j) { const unsigned c = xb_ld(&bar[XB_XCNT(j)]); sum += c; cnt += (c > 0u) ? 1u : 0u; mine = (j == x) ? c : mine; }
        if (sum == G) break;
        __builtin_amdgcn_s_sleep(1);
        if ((++sp & 255u) == 0u) { if (xb_ld(&bar[XB_TMO])) break; if (sp > XB_SPIN_CAP) { atomicAdd(&bar[XB_TMO], 1u); break; } }
    }
    nloc = mine > 0u ? mine : 1u; nx = cnt > 0u ? cnt : 1u;
}
__device__ __forceinline__ void xcd_barrier(const XcdBarrier& b) {
    asm volatile("s_waitcnt vmcnt(0)" ::: "memory");
    __syncthreads();
    if (tidx() == 0) {
        unsigned* bar = b.bar; unsigned bx = b.x; asm volatile("" : "+s"(bx));
        __builtin_amdgcn_s_waitcnt(0);
        unsigned nloc = b.st[0], nx = b.st[1];
        if (nloc == 0u) { xcd_barrier_complete(bar, bx, nloc, nx); b.st[0] = nloc; b.st[1] = nx; }
        const unsigned old = xb_add(&bar[XB_XSUB(bx)], 1u);
        const unsigned gen = old / nloc;
        if (old + 1u == (gen + 1u) * nloc) {
            __builtin_amdgcn_fence(__ATOMIC_RELEASE, "agent");
            asm volatile("s_waitcnt vmcnt(0)" ::: "memory");
            const unsigned og = xb_add(&bar[XB_TOP], 1u);
            const unsigned tg = og / nx;
            if (og + 1u == (tg + 1u) * nx) xb_add(&bar[XB_TOPGEN], 1u);
            else XB_SPIN(xb_ld(&bar[XB_TOPGEN]) == tg, bar);
            __builtin_amdgcn_fence(__ATOMIC_ACQUIRE, "agent");
            xb_add(&bar[XB_XGEN(bx)], 1u);
            asm volatile("s_waitcnt vmcnt(0)" ::: "memory");
        } else {
            XB_SPIN(xb_ld(&bar[XB_XGEN(bx)]) == gen, bar);
            __builtin_amdgcn_fence(__ATOMIC_ACQUIRE, "agent");
            asm volatile("s_waitcnt vmcnt(0)" ::: "memory");
        }
    }
    __syncthreads();
}

struct GemmD { const bf16_t* A; const bf16_t* Bt; int lda, ldb, nM, nN, nB, K; long long sA, sB; int xr; };

struct EpiUZ {
    bf16_t* uz;
    static constexpr int NPASS = 1;
    __device__ __forceinline__ void begin() {}
    template <bool FAST> __device__ __forceinline__ void row(int, int row, int pn, int c8, const float (&v0)[8], const float (&v1)[8]) {
        float o[8];
#pragma unroll
        for (int i = 0; i < 8; ++i) o[i] = v0[i] * silu_f(v1[i]);
        *(u32x4*)(uz + (size_t)row * EA + 128 * pn + c8) = pk8(o);
    }
    template <bool FAST> __device__ __forceinline__ void end(int, int, int, int) {}
};
struct EpiVT {
    static constexpr int NPASS = 3;
    bf16_t* vT; float* vstat; int pass; float cs[8], cq[8];
    __device__ __forceinline__ void begin() {
#pragma unroll
        for (int i = 0; i < 8; ++i) { cs[i] = 0.f; cq[i] = 0.f; } }
    template <bool FAST> __device__ __forceinline__ void row(int, int row, int pn, int c8, const float (&v0)[8], const float (&v1)[8]) {
        if (!FAST || pass == 0) { *(u32x4*)(vT + (size_t)row * T_ALL + 256 * pn + c8) = pk8(v0); *(u32x4*)(vT + (size_t)row * T_ALL + 256 * pn + 128 + c8) = pk8(v1); return; }
        if (pass == 1) {
#pragma unroll
            for (int i = 0; i < 8; ++i) { cs[i] += v0[i]; cq[i] += v0[i] * v0[i]; asm volatile("" : "+v"(cs[i]), "+v"(cq[i])); } }
        else {
#pragma unroll
            for (int i = 0; i < 8; ++i) { cs[i] += v1[i]; cq[i] += v1[i] * v1[i]; asm volatile("" : "+v"(cs[i]), "+v"(cq[i])); } }
    }
    template <bool FAST> __device__ __forceinline__ void end(int, int pm, int pn, int c8) {
        if (FAST && pass > 0) {
#pragma unroll
            for (int i = 0; i < 8; ++i) {
                cs[i] = red16(cs[i]); cq[i] = red16(cq[i]); }
            if ((tidx() & 15) == 0) { const int slot = pm * 2 + ((tidx() >> 8) & 1);
#pragma unroll
                for (int i = 0; i < 8; ++i) { const int tok = 256 * pn + (pass - 1) * 128 + c8 + i; *(float2*)(vstat + ((size_t)tok * 16 + slot) * 2) = make_float2(cs[i], cq[i]); } }
        }
    }
};
struct EpiOut {
    bf16_t* o; float* osq;
    static constexpr int NPASS = 1;
    __device__ __forceinline__ void begin() {}
    template <bool FAST> __device__ __forceinline__ void row(int, int row, int pn, int c8, const float (&v0)[8], const float (&v1)[8]) {
        *(u32x4*)(o + (size_t)row * D + 256 * pn + c8) = pk8(v0);
        *(u32x4*)(o + (size_t)row * D + 256 * pn + 128 + c8) = pk8(v1);
    }
    template <bool FAST> __device__ __forceinline__ void end(int, int, int, int) {}
};
struct EpiPart {
    static constexpr int NPASS = 1;
    float* P;
    __device__ __forceinline__ void begin() {}
    template <bool FAST> __device__ __forceinline__ void row(int b, int row, int pn, int c8, const float (&v0)[8], const float (&v1)[8]) {
        float* q = P + ((size_t)b * 512 + row) * D + 256 * pn + c8;
        *(f32x4*)q = (f32x4){v0[0], v0[1], v0[2], v0[3]}; *(f32x4*)(q + 4) = (f32x4){v0[4], v0[5], v0[6], v0[7]};
        *(f32x4*)(q + 128) = (f32x4){v1[0], v1[1], v1[2], v1[3]}; *(f32x4*)(q + 132) = (f32x4){v1[4], v1[5], v1[6], v1[7]};
    }
    template <bool FAST> __device__ __forceinline__ void end(int, int, int, int) {}
};
struct EpiInB {
    bf16_t* xh; bf16_t* sz; bf16_t* xbs;
    static constexpr int NPASS = 1;
    __device__ __forceinline__ void begin() {}
    template <bool FAST> __device__ __forceinline__ void row(int, int row, int pn, int c8, const float (&v0)[8], const float (&v1)[8]) {
        if (pn < 4) {
            const int c0 = 256 * pn + c8, c1 = c0 + 128;
            if (row < T_PR) { const int chunk = row >> 5, s = row & 31;
                *(u32x4*)(xh + ((size_t)(c0 >> 4) * NCHK + chunk) * XHW + s * 16 + (c0 & 15)) = pk8(v0);
                *(u32x4*)(xh + ((size_t)(c1 >> 4) * NCHK + chunk) * XHW + s * 16 + (c1 & 15)) = pk8(v1);
            } else { *(u32x4*)(xbs + (size_t)(row - T_PR) * D + c0) = pk8(v0); *(u32x4*)(xbs + (size_t)(row - T_PR) * D + c1) = pk8(v1); }
        } else {
            float a[8], b[8];
#pragma unroll
            for (int i = 0; i < 8; ++i) { a[i] = silu_f(v0[i]); b[i] = silu_f(v1[i]); }
            const int c0 = 256 * (pn - 4) + c8;
            *(u32x4*)(sz + (size_t)row * D + c0) = pk8(a);
            *(u32x4*)(sz + (size_t)row * D + c0 + 128) = pk8(b);
        }
    }
    template <bool FAST> __device__ __forceinline__ void end(int, int, int, int) {}
};
struct EpiS1 {
    float* S;
    static constexpr int NPASS = 1;
    __device__ __forceinline__ void begin() {}
    template <bool FAST> __device__ __forceinline__ void row(int g, int row, int, int c8, const float (&v0)[8], const float (&)[8]) {
        if (row < NCHK) { float* p = S + ((size_t)g * NCHK + row) * 128 + c8; *(f32x4*)p = (f32x4){v0[0], v0[1], v0[2], v0[3]}; *(f32x4*)(p + 4) = (f32x4){v0[4], v0[5], v0[6], v0[7]}; }
    }
    template <bool FAST> __device__ __forceinline__ void end(int, int, int, int) {}
};
struct EpiS3 {
    static constexpr int NPASS = 1;
    bf16_t* y;
    __device__ __forceinline__ void begin() {}
    __device__ __forceinline__ void one(int g, int chunk, int col, const float (&v)[8]) {
        const int t = col >> 4, j0 = col & 15; int tok;
        tok = chunk * 32 + t;
        float o[8];
#pragma unroll
        for (int i = 0; i < 8; ++i) o[i] = gelu_tanh_f(v[i]);
        *(u32x4*)(y + (size_t)tok * D + 16 * g + j0) = pk8(o);
    }
    template <bool FAST> __device__ __forceinline__ void row(int g, int row, int pn, int c8, const float (&v0)[8], const float (&v1)[8]) {
        if (row >= NCHK) return;
        one(g, row, 256 * pn + c8, v0); one(g, row, 256 * pn + 128 + c8, v1);
    }
    template <bool FAST> __device__ __forceinline__ void end(int, int, int, int) {}
};
struct EpiGlu {
    bf16_t* sz; const float* b1; const float* b2;
    static constexpr int NPASS = 1;
    __device__ __forceinline__ void begin() {}
    template <bool FAST> __device__ __forceinline__ void row(int, int row, int pn, int c8, const float (&v0)[8], const float (&v1)[8]) {
        const int c = 128 * pn + c8; bf16_t* p = sz + (size_t)row * D + c;
        float z[8], o[8]; unpk8(*(const u32x4*)p, z);
        const f32x4 p0 = *(const f32x4*)(b1 + c), p1 = *(const f32x4*)(b1 + c + 4), q0 = *(const f32x4*)(b2 + c), q1 = *(const f32x4*)(b2 + c + 4);
        const float bb1[8] = {p0[0], p0[1], p0[2], p0[3], p1[0], p1[1], p1[2], p1[3]}, bb2[8] = {q0[0], q0[1], q0[2], q0[3], q1[0], q1[1], q1[2], q1[3]};
#pragma unroll
        for (int i = 0; i < 8; ++i) o[i] = (v0[i] + bb1[i]) * sigmoid_f(v1[i] + bb2[i]) * z[i];
        *(u32x4*)p = pk8(o);
    }
    template <bool FAST> __device__ __forceinline__ void end(int, int, int, int) {}
    __device__ __forceinline__ void rowz(u32x4 zw, const float (&bb1)[8], const float (&bb2)[8], int row, int pn, int c8, const float (&v0)[8], const float (&v1)[8]) {
        float z[8], o[8]; unpk8(zw, z);
#pragma unroll
        for (int i = 0; i < 8; ++i) o[i] = (v0[i] + bb1[i]) * sigmoid_f(v1[i] + bb2[i]) * z[i];
        *(u32x4*)(sz + (size_t)row * D + 128 * pn + c8) = pk8(o);
    }
};

__device__ __forceinline__ float dot8(const float (&a)[8], u32x4 w) { float b[8]; unpk8(w, b); float s = 0.f;
#pragma unroll
    for (int i = 0; i < 8; ++i) s += a[i] * b[i];
    return s; }
template <class Epi> __device__ void gemm_naive(const GemmD g, Epi E) {
    const long long items = (long long)g.nB * g.nM * g.nN * 4096, nth = (long long)gridDim.x * blockDim.x;
    for (long long it = (long long)bidx() * blockDim.x + tidx(); it < items; it += nth) {
        const int rl = (int)(it & 255), c8 = (int)((it >> 8) & 15) * 8; const long long u = it >> 12;
        const int pm = (int)(u % g.nM); const long long u2 = u / g.nM; const int pn = (int)(u2 % g.nN), b = (int)(u2 / g.nN);
        const int row = pm * 256 + rl;
        const bf16_t* a = g.A + (size_t)b * g.sA + (size_t)row * g.lda;
        const bf16_t* bt = g.Bt + (size_t)b * g.sB + (size_t)(pn * 256 + c8) * g.ldb;
        float v0[8], v1[8];
#pragma unroll
        for (int i = 0; i < 8; ++i) { v0[i] = 0.f; v1[i] = 0.f; }
        for (int k = 0; k < g.K; k += 8) {
            float af[8]; unpk8(*(const u32x4*)(a + k), af);
#pragma unroll
            for (int i = 0; i < 8; ++i) { v0[i] += dot8(af, *(const u32x4*)(bt + (size_t)i * g.ldb + k)); v1[i] += dot8(af, *(const u32x4*)(bt + (size_t)(128 + i) * g.ldb + k)); }
        }
        E.begin(); E.template row<false>(b, row, pn, c8, v0, v1);
    }
}

constexpr int BM = 256, BK = 64, HALF = 128, HTB = HALF * BK * 2, STAGE_BYTES = 8 * HTB, NXCD = 8, WGM = 8;
__device__ __forceinline__ int lds_byte(int r, int c) { const int st = (r >> 4) * 2 + (c >> 5), rr = r & 15, cc = c & 31, ob = rr * 64 + cc * 2; return st * 1024 + (ob ^ (((ob >> 9) & 1) << 5)); }
__device__ __forceinline__ void stage_rc(int b, int& R, int& C) { const int st = b / 1024, sb = b % 1024, swz = sb ^ (((sb >> 9) & 1) << 5); R = (st >> 1) * 16 + swz / 64; C = (st & 1) * 32 + (swz % 64) / 2; }
__device__ __forceinline__ int perm32(int rho) { const int n = rho >> 4, i = rho & 15; return 8 * (i >> 2) + 4 * n + (i & 3); }
struct Unit { int b, pm, pn, w; };
struct Sched {
    int nM, nN, nB, nwg, G, c, n1, nM2, nN2, nwg2, xr;
    __device__ void init(const GemmD& g, const GemmD& g2, bool two, int G_, int c_) { nM = g.nM; nN = g.nN; nB = g.nB; nwg = nM * nN; G = G_; c = c_; n1 = nwg * nB; xr = g.xr;
        nM2 = two ? g2.nM : 0; nN2 = two ? g2.nN : 0; nwg2 = nM2 * nN2; }
    __device__ static void xcdmap(int L, int nM_, int nN_, int nwg_, Unit& u) {
        int wgid = L; { const int q = nwg_ / NXCD, r = nwg_ % NXCD, xcd = wgid % NXCD, off = wgid / NXCD; wgid = (xcd < r ? xcd * (q + 1) : r * (q + 1) + (xcd - r) * q) + off; }
        const int nig = WGM * nN_, gid = wgid / nig, fm = gid * WGM, gsz = (nM_ - fm) < WGM ? (nM_ - fm) : WGM;
        u.b = 0; u.pm = fm + ((wgid % nig) % gsz); u.pn = (wgid % nig) / gsz; }
    __device__ bool next(int i, Unit& u) const {
        const long L = (long)i * G + c; if (L >= (long)n1 + nwg2) return false;
        if (L >= n1) { u.w = 1; xcdmap((int)(L - n1), nM2, nN2, nwg2, u); return true; }
        u.w = 0;
        if (nB == 1) xcdmap((int)L, nM, nN, nwg, u);
        else { const int Lr = xr ? (int)((L & 7) * (n1 >> 3) + (L >> 3)) : (int)L;
            u.b = Lr / nwg; const int r = Lr % nwg; u.pm = r % nM; u.pn = r / nM; }
        return true;
    }
};
template <class Epi, class Epi2, bool TWO>
__device__ __forceinline__ void gemm_fast(LAS unsigned char* lds, const GemmD g, Epi E, const GemmD g2, Epi2 E2) {
    Sched S; S.init(g, g2, TWO, gridDim.x, bidx());
    int tid_ = tidx();
    const int tid = tid_, wid = __builtin_amdgcn_readfirstlane(tid >> 6), lane = tid & 63, wr = wid >> 2, wc = wid & 3, fr = lane & 15, fq = lane >> 4;
    const int K = g.K, nt = K / BK;
    unsigned voffA[2], voffB[2];
#pragma unroll
    for (int i = 0; i < 2; ++i) { int R, C; stage_rc(tid * 16 + i * 8192, R, C); const int Rb = (R & ~31) + perm32(R & 31);
        voffA[i] = (unsigned)(R * g.lda + C) * 2u; voffB[i] = (unsigned)(Rb * g.ldb + C) * 2u; }
    const size_t kstep = (size_t)(BK * 2);
    const size_t hstepA = (size_t)HALF * g.lda * 2, hstepB = (size_t)HALF * g.ldb * 2, tstepA = 2 * hstepA, tstepB = 2 * hstepB;
    const unsigned ldsw = (unsigned)wid * 1024u;
    const int aoff = lds_byte(wr * 64 + fr, fq * 8), boff = lds_byte(wc * 32 + fr, fq * 8);
#define PG8_SA(b, h) (((b) * 2 + (h)) * HTB)
#define PG8_SB(b, h) ((4 + (b) * 2 + (h)) * HTB)
#define PG8_STAGE(bufoff, gbase, voff) do { _Pragma("unroll") for (int _i = 0; _i < 2; ++_i) \
        __builtin_amdgcn_global_load_lds((const unsigned*)((const char*)(gbase) + (voff)[_i]), (LAS unsigned*)(lds + (bufoff) + ldsw + _i * 8192), 16, 0, 0); } while (0)
#define PG8_LDA(dst, b, h) do { _Pragma("unroll") for (int m = 0; m < 4; ++m) _Pragma("unroll") for (int k = 0; k < 2; ++k) dst[m][k] = *(const LAS bf16x8*)(lds + PG8_SA(b, h) + aoff + m * 2048 + k * 1024); } while (0)
#define PG8_LDB(dst, b, h) do { _Pragma("unroll") for (int n = 0; n < 2; ++n) _Pragma("unroll") for (int k = 0; k < 2; ++k) dst[n][k] = *(const LAS bf16x8*)(lds + PG8_SB(b, h) + boff + n * 2048 + k * 1024); } while (0)
#define PG8_MMA(ai, bj, At, Bt) do { __builtin_amdgcn_s_setprio(1); _Pragma("unroll") for (int m = 0; m < 4; ++m) _Pragma("unroll") for (int n = 0; n < 2; ++n) _Pragma("unroll") for (int k = 0; k < 2; ++k) \
        acc[ai][bj][m][n] = __builtin_amdgcn_mfma_f32_16x16x32_bf16(Bt[n][k], At[m][k], acc[ai][bj][m][n], 0, 0, 0); __builtin_amdgcn_s_setprio(0); } while (0)
#define PG8_WAIT_V(n) asm volatile("s_waitcnt vmcnt(" #n ")" ::: "memory")
#define PG8_WAIT_L(n) asm volatile("s_waitcnt lgkmcnt(" #n ")" ::: "memory")
#define PG8_BAR __builtin_amdgcn_s_barrier()
#define PG8_SCHED __builtin_amdgcn_sched_barrier(0)
    Unit cur, nxt; int ui = 0;
    if (!S.next(0, cur)) return;
    f32x4 acc[2][2][4][2];
#pragma unroll
    for (int a = 0; a < 2; ++a)
#pragma unroll
        for (int b = 0; b < 2; ++b)
#pragma unroll
            for (int m = 0; m < 4; ++m)
#pragma unroll
                for (int n = 0; n < 2; ++n) { const float z = zero_f(); acc[a][b][m][n] = (f32x4){z, z, z, z}; }
    bf16x8 At[4][2], B0[2][2], B1[2][2];
    const char* cA = ((TWO && cur.w) ? (const char*)g2.A : (const char*)g.A + (size_t)cur.b * g.sA * 2) + (size_t)cur.pm * tstepA;
    const char* cB = ((TWO && cur.w) ? (const char*)g2.Bt : (const char*)g.Bt + (size_t)cur.b * g.sB * 2) + (size_t)cur.pn * tstepB;
    PG8_STAGE(PG8_SB(0, 0), cB, voffB); PG8_STAGE(PG8_SA(0, 0), cA, voffA); PG8_STAGE(PG8_SB(0, 1), cB + hstepB, voffB); PG8_STAGE(PG8_SA(0, 1), cA + hstepA, voffA);
    if (wr == 1) PG8_BAR;
    PG8_WAIT_V(4); PG8_BAR;
    PG8_STAGE(PG8_SB(1, 0), cB + kstep, voffB); PG8_STAGE(PG8_SA(1, 0), cA + kstep, voffA); PG8_STAGE(PG8_SB(1, 1), cB + hstepB + kstep, voffB);
    PG8_WAIT_V(6); PG8_BAR;
    for (;;) {
        const bool has_next = S.next(ui + 1, nxt);
        const char* nA = has_next ? ((TWO && nxt.w) ? (const char*)g2.A : (const char*)g.A + (size_t)nxt.b * g.sA * 2) + (size_t)nxt.pm * tstepA : cA;
        const char* nB = has_next ? ((TWO && nxt.w) ? (const char*)g2.Bt : (const char*)g.Bt + (size_t)nxt.b * g.sB * 2) + (size_t)nxt.pn * tstepB : cB;
        for (int t = 0; t < nt; t += 2) {
            const bool last = (t == nt - 2);
            const char* a1 = cA + (size_t)(t + 1) * kstep;
            const char* a2 = last ? nA : cA + (size_t)(t + 2) * kstep; const char* b2 = last ? nB : cB + (size_t)(t + 2) * kstep;
            const char* a3 = a2 + kstep; const char* b3 = b2 + kstep;
            PG8_LDB(B0, 0, 0); PG8_SCHED; PG8_LDA(At, 0, 0); PG8_STAGE(PG8_SA(1, 1), a1 + hstepA, voffA);
            PG8_WAIT_L(8); PG8_BAR; PG8_WAIT_L(0); PG8_MMA(0, 0, At, B0); PG8_BAR; PG8_SCHED;
            PG8_LDB(B1, 0, 1); PG8_STAGE(PG8_SB(0, 0), b2, voffB);
            PG8_BAR; PG8_WAIT_L(0); PG8_MMA(0, 1, At, B1); PG8_BAR;
            PG8_LDA(At, 0, 1); PG8_STAGE(PG8_SA(0, 0), a2, voffA);
            PG8_BAR; PG8_WAIT_L(0); PG8_MMA(1, 0, At, B0); PG8_BAR; PG8_SCHED;
            PG8_STAGE(PG8_SB(0, 1), b2 + hstepB, voffB);
            PG8_WAIT_V(6); PG8_BAR; PG8_MMA(1, 1, At, B1); PG8_BAR;
            PG8_LDB(B0, 1, 0); PG8_SCHED; PG8_LDA(At, 1, 0); PG8_STAGE(PG8_SA(0, 1), a2 + hstepA, voffA);
            PG8_WAIT_L(8); PG8_BAR; PG8_WAIT_L(0); PG8_MMA(0, 0, At, B0); PG8_BAR; PG8_SCHED;
            PG8_LDB(B1, 1, 1); PG8_STAGE(PG8_SB(1, 0), b3, voffB);
            PG8_BAR; PG8_WAIT_L(0); PG8_MMA(0, 1, At, B1); PG8_BAR;
            PG8_LDA(At, 1, 1); PG8_STAGE(PG8_SA(1, 0), a3, voffA);
            PG8_BAR; PG8_WAIT_L(0); PG8_MMA(1, 0, At, B0); PG8_BAR; PG8_SCHED;
            PG8_STAGE(PG8_SB(1, 1), b3 + hstepB, voffB);
            PG8_WAIT_V(6); PG8_BAR; PG8_MMA(1, 1, At, B1); PG8_BAR;
        }
        int fr_e = fr, fq_e = fq; asm volatile("" : "+v"(fr_e), "+v"(fq_e));
        auto do_epi = [&](auto& EE) {
            using EpiT = typename std::remove_reference<decltype(EE)>::type;
            if constexpr (std::is_same<EpiT, EpiGlu>::value) {
                u32x4 zr[8]; float bb1[8], bb2[8];
                { const int c = 128 * cur.pn + wc * 32 + fq_e * 8; const f32x4 p0 = *(const f32x4*)(EE.b1 + c), p1 = *(const f32x4*)(EE.b1 + c + 4), q0 = *(const f32x4*)(EE.b2 + c), q1 = *(const f32x4*)(EE.b2 + c + 4);
#pragma unroll
                  for (int i = 0; i < 4; ++i) { bb1[i] = p0[i]; bb1[4 + i] = p1[i]; bb2[i] = q0[i]; bb2[4 + i] = q1[i]; } }
#pragma unroll
                for (int ai = 0; ai < 2; ++ai)
#pragma unroll
                    for (int m = 0; m < 4; ++m) zr[ai * 4 + m] = *(const u32x4*)(EE.sz + (size_t)(cur.pm * BM + ai * HALF + wr * 64 + m * 16 + fr_e) * D + 128 * cur.pn + wc * 32 + fq_e * 8);
#pragma unroll
                for (int ai = 0; ai < 2; ++ai)
#pragma unroll
                    for (int m = 0; m < 4; ++m) {
                        const float v0[8] = {acc[ai][0][m][0][0], acc[ai][0][m][0][1], acc[ai][0][m][0][2], acc[ai][0][m][0][3], acc[ai][0][m][1][0], acc[ai][0][m][1][1], acc[ai][0][m][1][2], acc[ai][0][m][1][3]};
                        const float v1[8] = {acc[ai][1][m][0][0], acc[ai][1][m][0][1], acc[ai][1][m][0][2], acc[ai][1][m][0][3], acc[ai][1][m][1][0], acc[ai][1][m][1][1], acc[ai][1][m][1][2], acc[ai][1][m][1][3]};
                        int fr_i = fr_e, fq_i = fq_e; asm volatile("" : "+v"(fr_i), "+v"(fq_i));
                        EE.rowz(zr[ai * 4 + m], bb1, bb2, cur.pm * BM + ai * HALF + wr * 64 + m * 16 + fr_i, cur.pn, wc * 32 + fq_i * 8, v0, v1);
                        __builtin_amdgcn_sched_barrier(0);
                    }
            } else
            {
#pragma unroll
            for (int pass = 0; pass < EpiT::NPASS; ++pass) {
                if constexpr (EpiT::NPASS > 1) EE.pass = pass;
                EE.begin();
#pragma unroll
                for (int ai = 0; ai < 2; ++ai)
#pragma unroll
                    for (int m = 0; m < 4; ++m) {
                        const float v0[8] = {acc[ai][0][m][0][0], acc[ai][0][m][0][1], acc[ai][0][m][0][2], acc[ai][0][m][0][3], acc[ai][0][m][1][0], acc[ai][0][m][1][1], acc[ai][0][m][1][2], acc[ai][0][m][1][3]};
                        const float v1[8] = {acc[ai][1][m][0][0], acc[ai][1][m][0][1], acc[ai][1][m][0][2], acc[ai][1][m][0][3], acc[ai][1][m][1][0], acc[ai][1][m][1][1], acc[ai][1][m][1][2], acc[ai][1][m][1][3]};
                        int fr_i = fr_e, fq_i = fq_e; asm volatile("" : "+v"(fr_i), "+v"(fq_i));
                        EE.template row<true>(cur.b, cur.pm * BM + ai * HALF + wr * 64 + m * 16 + fr_i, cur.pn, wc * 32 + fq_i * 8, v0, v1);
                        if (m & 1) { asm volatile("" ::: "memory"); __builtin_amdgcn_sched_barrier(0); }
                    }
                EE.template end<true>(cur.b, cur.pm, cur.pn, wc * 32 + fq_e * 8);
            }
            }
        };
        if (TWO && cur.w) do_epi(E2); else do_epi(E);
        if (!has_next) break;
#pragma unroll
        for (int a = 0; a < 2; ++a)
#pragma unroll
            for (int b = 0; b < 2; ++b)
#pragma unroll
                for (int m = 0; m < 4; ++m)
#pragma unroll
                    for (int n = 0; n < 2; ++n) { const float z = zero_f(); acc[a][b][m][n] = (f32x4){z, z, z, z}; }
        cur = nxt; cA = nA; cB = nB; ++ui;
    }
    PG8_WAIT_V(0);
    if (wr == 0) PG8_BAR;
    PG8_BAR;
#undef PG8_SA
#undef PG8_SB
#undef PG8_STAGE
#undef PG8_LDA
#undef PG8_LDB
#undef PG8_MMA
#undef PG8_WAIT_V
#undef PG8_WAIT_L
#undef PG8_BAR
#undef PG8_SCHED
}
#ifndef FMASK
#define FMASK 0xff
#endif
template <int ID, class Epi> __device__ __forceinline__ void run_gemm(LAS unsigned char* lds, const GemmD& g, const Epi& E) {
#if FAST_GEMM
#ifndef PROBE_MASK
#define PROBE_MASK 0
#endif
    for (int r = 0; r < (((PROBE_MASK >> ID) & 1) ? 2 : 1); ++r) { if ((FMASK >> ID) & 1) gemm_fast<Epi, Epi, false>(lds, g, E, g, E); else gemm_naive<Epi>(g, E); }
#else
    gemm_naive<Epi>(g, E);
#endif
}

__device__ __forceinline__ int nmap(int kind, int n) {
    if (kind == 0) { if (n < 2048) return 256 * (n >> 7) + (n & 127); if (n < 4096) return 4096 + (n - 2048); const int c = n - 4096; return 256 * (c >> 7) + 128 + (c & 127); }
    if (kind == 3) return 256 * (n >> 7) + (n & 127);
    if (kind == 4) return 256 * (n >> 7) + 128 + (n & 127);
    return n;
}
struct WTile { const float* src; bf16_t* dst; int kind, K, N, k0, n0; };
__device__ __forceinline__ WTile wtile(const Params& p, int tt) {
    WTile w; const int j = tt / 3328; int r = tt % 3328;
    if (r < 1536) { w.kind = 0; w.K = 1024; w.N = 6144; w.src = p.in[6] + (size_t)j * 1024 * 6144; w.dst = (bf16_t*)(p.ws + OFF_WINA) + (size_t)j * 6144 * 1024; }
    else if (r < 2048) { r -= 1536; w.kind = 1; w.K = 2048; w.N = 1024; w.src = p.in[11] + (size_t)j * 2048 * 1024; w.dst = (bf16_t*)(p.ws + OFF_WOUTA) + (size_t)j * 1024 * 2048; }
    else if (r < 2560) { r -= 2048; w.kind = 2; w.K = 1024; w.N = 2048; w.src = p.in[12] + (size_t)j * 1024 * 2048; w.dst = (bf16_t*)(p.ws + OFF_WINB) + (size_t)j * 2048 * 1024; }
    else if (r < 2816) { r -= 2560; w.kind = 3; w.K = 1024; w.N = 1024; w.src = p.in[21] + (size_t)j * 1024 * 1024; w.dst = (bf16_t*)(p.ws + OFF_WGLU) + (size_t)j * 2048 * 1024; }
    else if (r < 3072) { r -= 2816; w.kind = 4; w.K = 1024; w.N = 1024; w.src = p.in[23] + (size_t)j * 1024 * 1024; w.dst = (bf16_t*)(p.ws + OFF_WGLU) + (size_t)j * 2048 * 1024; }
    else { r -= 3072; w.kind = 5; w.K = 1024; w.N = 1024; w.src = p.in[25] + (size_t)j * 1024 * 1024; w.dst = (bf16_t*)(p.ws + OFF_WOUTB) + (size_t)j * 1024 * 1024; }
    const int ntn = w.N / 64; w.k0 = (r / ntn) * 64; w.n0 = (r % ntn) * 64; return w;
}
__device__ __forceinline__ void convert_weights(const Params& p, float* lt, int t_lo, int t_hi, int wg_lo) {
    if (bidx() < wg_lo) return;
    const int tid = tidx(), stride = gridDim.x - wg_lo; float r[8];
    int tt = t_lo + bidx() - wg_lo;
    if (tt < t_hi) { const WTile w = wtile(p, tt);
#pragma unroll
        for (int i = 0; i < 8; ++i) r[i] = w.src[(size_t)(w.k0 + (tid >> 6) + 8 * i) * w.N + w.n0 + (tid & 63)]; }
    for (; tt < t_hi; tt += stride) {
        const WTile w = wtile(p, tt);
#pragma unroll
        for (int i = 0; i < 8; ++i) lt[((tid >> 6) + 8 * i) * 65 + (tid & 63)] = r[i];
        __syncthreads();
        if (tt + stride < t_hi) { const WTile wn = wtile(p, tt + stride);
#pragma unroll
            for (int i = 0; i < 8; ++i) r[i] = wn.src[(size_t)(wn.k0 + (tid >> 6) + 8 * i) * wn.N + wn.n0 + (tid & 63)]; }
        { const int nn = tid >> 3, k8 = tid & 7; float v[8];
#pragma unroll
          for (int i = 0; i < 8; ++i) v[i] = lt[(k8 * 8 + i) * 65 + nn];
          *(u32x4*)(w.dst + (size_t)nmap(w.kind, w.n0 + nn) * w.K + w.k0 + k8 * 8) = pk8(v); }
        __syncthreads();
    }
}
__device__ __forceinline__ void rownorm_phase(const Params& p, bool first, bool xin_input, const bf16_t* oraw, const float* osq, const float* part, const float* gpost, const float* gpre, bool write_hn) {
    const int lane = tidx() & 63, wv = (bidx() * blockDim.x + tidx()) >> 6, nw = (gridDim.x * blockDim.x) >> 6;
    bf16_t* hn = (bf16_t*)(p.ws + OFF_HN);
    f32x4 gp[4], gq[4];
#pragma unroll
    for (int i = 0; i < 4; ++i) { gp[i] = first ? (f32x4){0.f, 0.f, 0.f, 0.f} : *(const f32x4*)(gpost + i * 256 + lane * 4); gq[i] = *(const f32x4*)(gpre + i * 256 + lane * 4); }
    auto finish = [&](int row, f32x4 (&x)[4]) {
        float* xout = p.out + (size_t)row * D;
        if (!first) {
#pragma unroll
            for (int i = 0; i < 4; ++i) *(f32x4*)(xout + i * 256 + lane * 4) = x[i]; }
        if (write_hn) {
            float q = 0.f;
#pragma unroll
            for (int i = 0; i < 4; ++i) q += x[i][0] * x[i][0] + x[i][1] * x[i][1] + x[i][2] * x[i][2] + x[i][3] * x[i][3];
#pragma unroll
            for (int o = 1; o < 64; o <<= 1) q += shfl_xor_f(q, o);
            const float r2 = rsqrtf(q * (1.f / D) + EPS);
#pragma unroll
            for (int i = 0; i < 4; ++i) { u32x2 w; w.x = pk2(x[i][0] * r2 * gq[i][0], x[i][1] * r2 * gq[i][1]); w.y = pk2(x[i][2] * r2 * gq[i][2], x[i][3] * r2 * gq[i][3]);
                *(u32x2*)(hn + (size_t)row * D + i * 256 + lane * 4) = w; }
        }
    };
    auto load = [&](int row, f32x4 (&x)[4], u32x2 (&w)[4], float& qs) {
        const float* xin = xin_input ? p.in[0] + (size_t)row * D : p.out + (size_t)row * D;
#pragma unroll
        for (int i = 0; i < 4; ++i) x[i] = __builtin_nontemporal_load((const f32x4*)(xin + i * 256 + lane * 4));
        if (!first) { qs = 0.f;
#pragma unroll
            for (int i = 0; i < 4; ++i) w[i] = __builtin_nontemporal_load((const u32x2*)(oraw + (size_t)row * D + i * 256 + lane * 4)); }
    };
    int row = wv;
    f32x4 xa[4], xb[4]; u32x2 wa[4], wb[4]; float qa = 0.f, qb = 0.f;
    if (row < T_PR) load(row, xa, wa, qa);
    for (; row < T_PR; row += nw) {
        const int nxt = row + nw;
        if (nxt < T_PR) load(nxt, xb, wb, qb);
        if (!first) {
            float qs = 0.f;
#pragma unroll
            for (int i = 0; i < 4; ++i) { const float a0 = bflo(wa[i].x), a1 = bfhi(wa[i].x), a2 = bflo(wa[i].y), a3 = bfhi(wa[i].y); qs += (a0 * a0 + a1 * a1) + (a2 * a2 + a3 * a3); }
#pragma unroll
            for (int o = 1; o < 64; o <<= 1) qs += shfl_xor_f(qs, o);
            const float rs = rsqrtf(qs * (1.f / D) + EPS);
#pragma unroll
            for (int i = 0; i < 4; ++i) { xa[i][0] += bflo(wa[i].x) * rs * gp[i][0]; xa[i][1] += bfhi(wa[i].x) * rs * gp[i][1]; xa[i][2] += bflo(wa[i].y) * rs * gp[i][2]; xa[i][3] += bfhi(wa[i].y) * rs * gp[i][3]; }
        }
        finish(row, xa);
#pragma unroll
        for (int i = 0; i < 4; ++i) { xa[i] = xb[i]; wa[i] = wb[i]; }
        qa = qb;
    }
    if (row < T_ALL) {
        f32x4 x[4];
        const float* xin = xin_input ? p.in[1] + (size_t)(row - T_PR) * D : p.out + (size_t)row * D;
#pragma unroll
        for (int i = 0; i < 4; ++i) x[i] = *(const f32x4*)(xin + i * 256 + lane * 4);
        if (!first) {
            f32x4 o4[4]; float qs = 0.f;
#pragma unroll
            for (int i = 0; i < 4; ++i) { const float* q = part + (size_t)(row - T_PR) * D + i * 256 + lane * 4;
                o4[i] = (*(const f32x4*)q + *(const f32x4*)(q + 512 * D)) + (*(const f32x4*)(q + 2 * 512 * D) + *(const f32x4*)(q + 3 * 512 * D));
                qs += o4[i][0] * o4[i][0] + o4[i][1] * o4[i][1] + o4[i][2] * o4[i][2] + o4[i][3] * o4[i][3]; }
#pragma unroll
            for (int o = 1; o < 64; o <<= 1) qs += shfl_xor_f(qs, o);
            const float rs = rsqrtf(qs * (1.f / D) + EPS);
#pragma unroll
            for (int i = 0; i < 4; ++i) x[i] += o4[i] * rs * gp[i];
        }
        finish(row, x);
    }
}
__device__ __forceinline__ void ssm_tables(const Params& p) {
    const int gt = bidx() * blockDim.x + tidx(), nth = gridDim.x * blockDim.x;
    float* coef = (float*)(p.ws + OFF_COEF); float* tabE = (float*)(p.ws + OFF_TABE);
    for (int it = gt; it < 2 * 64 * 33 * 64; it += nth) {
        const int pp = it & 63, tau = (it >> 6) % 33, jg = it / (64 * 33);
        const float dt = __expf(p.in[15][jg]), ar = p.in[13][jg * 64 + pp], ai = p.in[14][jg * 64 + pp];
        const float mag = expf((float)tau * dt * ar); float sn, cs; sincosf((float)tau * dt * ai, &sn, &cs);
        tabE[(size_t)it * 2] = mag * cs; tabE[(size_t)it * 2 + 1] = mag * sn;
        if (tau == 1) { const float nr = mag * cs - 1.f, ni = mag * sn, den = ar * ar + ai * ai;
            coef[(jg * 64 + pp) * 2] = (nr * ar + ni * ai) / den; coef[(jg * 64 + pp) * 2 + 1] = (ni * ar - nr * ai) / den; }
    }
}
__device__ __forceinline__ void ssm_ktab(const Params& p, float* lt, int u_lo, int u_hi, int wg_lo) {
    if (bidx() < wg_lo) return;
    const int tid = tidx(); float* Ktab = (float*)(p.ws + OFF_KTAB);
    float* F = lt; float* Bs = lt + 512; float* CF = lt + 512 + 2048;
    for (int u = u_lo + bidx() - wg_lo; u < u_hi; u += gridDim.x - wg_lo) {
        const int jg = u >> 3, tau0 = (u & 7) * 4;
        if (tid < 256) { const int tl = tid >> 6, pp = tid & 63, tau = tau0 + tl;
            const float dt = expf(p.in[15][jg]), ar = p.in[13][jg * 64 + pp], ai = p.in[14][jg * 64 + pp];
            float m1 = expf(dt * ar), s1, c1; sincosf(dt * ai, &s1, &c1);
            const float nr = m1 * c1 - 1.f, ni = m1 * s1, den = ar * ar + ai * ai, cr = (nr * ar + ni * ai) / den, ci = (ni * ar - nr * ai) / den;
            float mt = expf((float)tau * dt * ar), st, ct; sincosf((float)tau * dt * ai, &st, &ct);
            const float er = mt * ct, ei = mt * st;
            F[(tl * 64 + pp) * 2] = er * cr - ei * ci; F[(tl * 64 + pp) * 2 + 1] = er * ci + ei * cr; }
#pragma unroll
        for (int i = 0; i < 2; ++i) { const int e = tid + 512 * i;
            Bs[e * 2] = p.in[16][(size_t)jg * 1024 + e]; Bs[e * 2 + 1] = p.in[17][(size_t)jg * 1024 + e]; }
        __syncthreads();
#pragma unroll
        for (int i = 0; i < 8; ++i) { const int e = tid + 512 * i, pp = e & 63, jj = (e >> 6) & 15, tl = e >> 10;
            const float c_r = p.in[18][((size_t)jg * 16 + jj) * 64 + pp], c_i = p.in[19][((size_t)jg * 16 + jj) * 64 + pp], fr_ = F[(tl * 64 + pp) * 2], fi_ = F[(tl * 64 + pp) * 2 + 1];
            CF[e * 2] = c_r * fr_ - c_i * fi_; CF[e * 2 + 1] = c_r * fi_ + c_i * fr_; }
        __syncthreads();
#pragma unroll
        for (int i = 0; i < 2; ++i) { const int e = tid + 512 * i, k = e & 15, jj = (e >> 4) & 15, tl = e >> 8; float acc = 0.f;
            const float* cf = CF + (size_t)(tl * 16 + jj) * 128;
#pragma unroll 8
            for (int pp = 0; pp < 64; ++pp) acc += cf[pp * 2] * Bs[(pp * 16 + k) * 2] - cf[pp * 2 + 1] * Bs[(pp * 16 + k) * 2 + 1];
            if (tau0 + tl == 0 && jj == k) acc += p.in[20][(size_t)jg * 16 + jj];
            Ktab[((size_t)jg * 32 + tau0 + tl) * 256 + jj * 16 + k] = acc; }
        __syncthreads();
    }
}
__device__ __forceinline__ void ws_prep(const Params& p) {
    const int gt = bidx() * blockDim.x + tidx(), nth = gridDim.x * blockDim.x;
    bf16_t* wsb = (bf16_t*)(p.ws + OFF_WSB); float* rs = (float*)(p.ws + OFF_RS);
    for (int it = gt; it < 2 * 8 * 128 * 128; it += nth) { const int s = it & 127, t = (it >> 7) & 127; wsb[it] = f2bf(s <= t ? p.in[9][it] : 0.f); }
    { const int lane = tidx() & 63, wv = gt >> 6, nw = nth >> 6;
      for (int it = wv; it < 2 * 8 * 128; it += nw) { const int t = it & 127;
          float a = (lane <= t ? p.in[9][(size_t)it * 128 + lane] : 0.f) + (64 + lane <= t ? p.in[9][(size_t)it * 128 + 64 + lane] : 0.f);
#pragma unroll
          for (int o = 1; o < 64; o <<= 1) a += shfl_xor_f(a, o);
          if (lane == 0) rs[it] = a; } }
}
__device__ __forceinline__ void ssm_build(const Params& p, int j, int wg_lo) {
    if (bidx() < wg_lo) return;
    const long long gt = (long long)(bidx() - wg_lo) * blockDim.x + tidx(), nth = (long long)(gridDim.x - wg_lo) * blockDim.x;
    const float* Ktab = (const float*)(p.ws + OFF_KTAB) + (size_t)j * 64 * 32 * 256; const float* tabE = (const float*)(p.ws + OFF_TABE) + (size_t)j * 64 * 33 * 64 * 2;
    const float* coef = (const float*)(p.ws + OFF_COEF) + (size_t)j * 64 * 64 * 2;
    bf16_t* TV = (bf16_t*)(p.ws + OFF_TV); bf16_t* WG = (bf16_t*)(p.ws + OFF_WG); bf16_t* XH = (bf16_t*)(p.ws + OFF_XH);
    auto t_item = [&](long long it, u32x4& outv, size_t& off) {
        const int cg8 = (int)(it & 63), rowi = (int)((it >> 6) & 511), g = (int)(it >> 15); const int t = rowi >> 4, jj = rowi & 15, s = cg8 >> 1, k0 = (cg8 & 1) * 8; float v[8];
        if (s <= t) { const float* kp = Ktab + ((size_t)g * 32 + (t - s)) * 256 + jj * 16 + k0; const f32x4 a = *(const f32x4*)kp, b = *(const f32x4*)(kp + 4);
            v[0] = a[0]; v[1] = a[1]; v[2] = a[2]; v[3] = a[3]; v[4] = b[0]; v[5] = b[1]; v[6] = b[2]; v[7] = b[3]; }
        else {
#pragma unroll
            for (int i = 0; i < 8; ++i) v[i] = 0.f; }
        outv = pk8(v); off = ((size_t)g * 512 + rowi) * 640 + cg8 * 8;
    };
    for (long long it = gt; it < 64LL * 512 * 64; it += 4 * nth) {
        u32x4 o4[4]; size_t of[4];
#pragma unroll
        for (int u = 0; u < 4; ++u) if (it + u * nth < 64LL * 512 * 64) t_item(it + u * nth, o4[u], of[u]);
#pragma unroll
        for (int u = 0; u < 4; ++u) if (it + u * nth < 64LL * 512 * 64) *(u32x4*)(TV + of[u]) = o4[u];
    }
    auto v_item = [&](long long it, u32x4& outv, size_t& off) {
        const int q = (int)(it & 15), rowi = (int)((it >> 4) & 511), g = (int)(it >> 13); const int t = rowi >> 4, jj = rowi & 15, im = q >> 3, p0 = (q & 7) * 8; float v[8];
        const float* ep = tabE + (((size_t)g * 33 + t + 1) * 64 + p0) * 2; const f32x4 e0 = *(const f32x4*)ep, e1 = *(const f32x4*)(ep + 4), e2 = *(const f32x4*)(ep + 8), e3 = *(const f32x4*)(ep + 12);
        const float* crp = p.in[18] + (((size_t)j * 64 + g) * 16 + jj) * 64 + p0; const float* cip = p.in[19] + (((size_t)j * 64 + g) * 16 + jj) * 64 + p0;
        const f32x4 cr0 = *(const f32x4*)crp, cr1 = *(const f32x4*)(crp + 4), ci0 = *(const f32x4*)cip, ci1 = *(const f32x4*)(cip + 4);
        const float er[8] = {e0[0], e0[2], e1[0], e1[2], e2[0], e2[2], e3[0], e3[2]}, ei[8] = {e0[1], e0[3], e1[1], e1[3], e2[1], e2[3], e3[1], e3[3]};
        const float c_r[8] = {cr0[0], cr0[1], cr0[2], cr0[3], cr1[0], cr1[1], cr1[2], cr1[3]}, c_i[8] = {ci0[0], ci0[1], ci0[2], ci0[3], ci1[0], ci1[1], ci1[2], ci1[3]};
#pragma unroll
        for (int i = 0; i < 8; ++i) v[i] = im ? -(c_r[i] * ei[i] + c_i[i] * er[i]) : (c_r[i] * er[i] - c_i[i] * ei[i]);
        outv = pk8(v); off = ((size_t)g * 512 + rowi) * 640 + 512 + q * 8;
    };
    for (long long it = gt; it < 64LL * 512 * 16; it += 4 * nth) {
        u32x4 o4[4]; size_t of[4];
#pragma unroll
        for (int u = 0; u < 4; ++u) if (it + u * nth < 64LL * 512 * 16) v_item(it + u * nth, o4[u], of[u]);
#pragma unroll
        for (int u = 0; u < 4; ++u) if (it + u * nth < 64LL * 512 * 16) *(u32x4*)(TV + of[u]) = o4[u];
    }
    auto w_item = [&](long long it, u32x4& outv, size_t& off) {
        const int cg8 = (int)(it & 63), rowi = (int)((it >> 6) & 127), g = (int)(it >> 13); const int im = rowi >> 6, pp = rowi & 63, s = cg8 >> 1, k0 = (cg8 & 1) * 8;
        const float er = tabE[(((size_t)g * 33 + 31 - s) * 64 + pp) * 2], ei = tabE[(((size_t)g * 33 + 31 - s) * 64 + pp) * 2 + 1], cr = coef[(g * 64 + pp) * 2], ci = coef[(g * 64 + pp) * 2 + 1];
        const float fr_ = er * cr - ei * ci, fi_ = er * ci + ei * cr; float v[8];
        const float* brp = p.in[16] + (((size_t)j * 64 + g) * 64 + pp) * 16 + k0; const float* bip = p.in[17] + (((size_t)j * 64 + g) * 64 + pp) * 16 + k0;
        const f32x4 br0 = *(const f32x4*)brp, br1 = *(const f32x4*)(brp + 4), bi0 = *(const f32x4*)bip, bi1 = *(const f32x4*)(bip + 4);
        const float br[8] = {br0[0], br0[1], br0[2], br0[3], br1[0], br1[1], br1[2], br1[3]}, bi[8] = {bi0[0], bi0[1], bi0[2], bi0[3], bi1[0], bi1[1], bi1[2], bi1[3]};
#pragma unroll
        for (int i = 0; i < 8; ++i) v[i] = im ? (fr_ * bi[i] + fi_ * br[i]) : (fr_ * br[i] - fi_ * bi[i]);
        outv = pk8(v); off = ((size_t)g * 128 + rowi) * 512 + cg8 * 8;
    };
    for (long long it = gt; it < 64LL * 128 * 64; it += 4 * nth) {
        u32x4 o4[4]; size_t of[4];
#pragma unroll
        for (int u = 0; u < 4; ++u) if (it + u * nth < 64LL * 128 * 64) w_item(it + u * nth, o4[u], of[u]);
#pragma unroll
        for (int u = 0; u < 4; ++u) if (it + u * nth < 64LL * 128 * 64) *(u32x4*)(WG + of[u]) = o4[u];
    }
}
__device__ __forceinline__ void ssm_mid(const Params& p, int j, LAS unsigned char* lds) {
    const int c = bidx(), tid = tidx(), wid = tid >> 6, lane = tid & 63;
    const float* tabE = (const float*)(p.ws + OFF_TABE) + (size_t)j * 64 * 33 * 64 * 2; const float* S = (const float*)(p.ws + OFF_S); bf16_t* XH = (bf16_t*)(p.ws + OFF_XH);
    if (c < 128) {
        asm volatile("s_waitcnt vmcnt(0)" ::: "memory"); __syncthreads();
        if (tid < 256) { const int g = c >> 1, b = 4 * (c & 1) + wid, pp = lane;
            const float ar = tabE[(((size_t)g * 33 + 32) * 64 + pp) * 2], ai = tabE[(((size_t)g * 33 + 32) * 64 + pp) * 2 + 1];
            float hr = 0.f, hi = 0.f;
            for (int c0 = 0; c0 < 64; c0 += 32) { float sr[32], si[32];
#pragma unroll
                for (int k = 0; k < 32; ++k) { const size_t ch = (size_t)g * NCHK + b * 64 + c0 + k; sr[k] = S[ch * 128 + pp]; si[k] = S[ch * 128 + 64 + pp]; }
#pragma unroll
                for (int k = 0; k < 32; ++k) { const size_t ch = (size_t)g * NCHK + b * 64 + c0 + k;
                    XH[ch * XHW + 512 + pp] = f2bf(hr); XH[ch * XHW + 576 + pp] = f2bf(hi);
                    const float nr = ar * hr - ai * hi + sr[k], ni = ar * hi + ai * hr + si[k]; hr = nr; hi = ni; } }
            p.out[OUT_RP + (((size_t)j * 8 + b) * 64 + g) * 64 + pp] = hr; p.out[OUT_IP + (((size_t)j * 8 + b) * 64 + g) * 64 + pp] = hi; }
    } else {
        const int wb = c - 128, g = wb & 63, jg = j * 64 + g, pp = lane;
        LAS float* Cr = (LAS float*)lds; LAS float* Ci = Cr + 1088; LAS float* Hs = Cr + 2176 + wid * 512;
#pragma unroll
        for (int i = 0; i < 2; ++i) { const int e = tid + 512 * i, jj = e >> 6, q = e & 63;
            Cr[jj * 68 + q] = p.in[18][((size_t)jg * 16 + jj) * 64 + q]; Ci[jj * 68 + q] = p.in[19][((size_t)jg * 16 + jj) * 64 + q]; }
        __syncthreads();
        const float abr = tabE[(((size_t)g * 33 + 1) * 64 + pp) * 2], abi = tabE[(((size_t)g * 33 + 1) * 64 + pp) * 2 + 1];
        const float* coef = (const float*)(p.ws + OFF_COEF) + (size_t)j * 64 * 64 * 2; const float cr = coef[(g * 64 + pp) * 2], ci = coef[(g * 64 + pp) * 2 + 1];
        float Bbr[16], Bbi[16];
#pragma unroll
        for (int k4 = 0; k4 < 4; ++k4) { const f32x4 br = *(const f32x4*)(p.in[16] + ((size_t)jg * 64 + pp) * 16 + k4 * 4), bi = *(const f32x4*)(p.in[17] + ((size_t)jg * 64 + pp) * 16 + k4 * 4);
#pragma unroll
            for (int k = 0; k < 4; ++k) { Bbr[k4 * 4 + k] = cr * br[k] - ci * bi[k]; Bbi[k4 * 4 + k] = cr * bi[k] + ci * br[k]; } }
        const bf16_t* xbs = (const bf16_t*)(p.ws + OFF_XBS); bf16_t* ybuf = (bf16_t*)(p.ws + OFF_HN);
        const int s_l = lane >> 4, j_l = lane & 15; const float dsk = p.in[20][(size_t)jg * 16 + j_l];
        const int b0 = 64 * (wb >> 6) + 8 * wid;
        bf16_t nx = xbs[(size_t)(4 * b0 + s_l) * D + 16 * g + j_l]; float nhr = p.in[2][(((size_t)j * 128 + b0) * 64 + g) * 64 + pp], nhi = p.in[3][(((size_t)j * 128 + b0) * 64 + g) * 64 + pp];
        for (int i = 0; i < 8; ++i) { const int b = b0 + i;
            const float xv = bf2f(nx);
            const size_t si_ = (((size_t)j * 128 + b) * 64 + g) * 64 + pp; float hr = nhr, hi = nhi;
            if (i < 7) { nx = xbs[(size_t)(4 * (b + 1) + s_l) * D + 16 * g + j_l]; nhr = p.in[2][si_ + 4096]; nhi = p.in[3][si_ + 4096]; }
#pragma unroll
            for (int s2 = 0; s2 < 4; ++s2) { float bur = 0.f, bui = 0.f;
#pragma unroll
                for (int k = 0; k < 16; ++k) { const float xs = __int_as_float(__builtin_amdgcn_readlane(__float_as_int(xv), s2 * 16 + k)); bur += Bbr[k] * xs; bui += Bbi[k] * xs; }
                const float nr = abr * hr - abi * hi + bur, ni = abr * hi + abi * hr + bui; hr = nr; hi = ni;
                Hs[s2 * 64 + pp] = hr; Hs[256 + s2 * 64 + pp] = hi; }
            p.out[OUT_RS + si_] = hr; p.out[OUT_IS + si_] = hi;
            asm volatile("s_waitcnt lgkmcnt(0)" ::: "memory");
            float acc = 0.f;
#pragma unroll 4
            for (int q = 0; q < 64; q += 4) { const f32x4 c4r = *(const LAS f32x4*)(Cr + j_l * 68 + q), c4i = *(const LAS f32x4*)(Ci + j_l * 68 + q), h4r = *(const LAS f32x4*)(Hs + s_l * 64 + q), h4i = *(const LAS f32x4*)(Hs + 256 + s_l * 64 + q);
                acc += (c4r[0] * h4r[0] - c4i[0] * h4i[0]) + (c4r[1] * h4r[1] - c4i[1] * h4i[1]) + (c4r[2] * h4r[2] - c4i[2] * h4i[2]) + (c4r[3] * h4r[3] - c4i[3] * h4i[3]); }
            ybuf[(size_t)(T_PR + 4 * b + s_l) * D + 16 * g + j_l] = f2bf(gelu_tanh_f(acc + dsk * xv));
            asm volatile("s_waitcnt lgkmcnt(0)" ::: "memory");
        }
    }
}
__device__ __forceinline__ void load_mu_rstd(const float* vstat, int tok, float& mu, float& rstd) {
    float a = 0.f, q = 0.f;
#pragma unroll
    for (int k = 0; k < 16; ++k) { const float2 w = *(const float2*)(vstat + ((size_t)tok * 16 + k) * 2); a += w.x; q += w.y; }
    mu = a * (1.f / EA); rstd = rsqrtf(q * (1.f / EA) - mu * mu + EPS);
}
__device__ __forceinline__ void vstat_naive(const Params& p) {
    const int gt = bidx() * blockDim.x + tidx(), nth = gridDim.x * blockDim.x;
    const bf16_t* vT = (const bf16_t*)(p.ws + OFF_VT); float* vstat = (float*)(p.ws + OFF_VSTAT);
    for (int tok = gt; tok < T_ALL; tok += nth) { float a = 0.f, q = 0.f;
        for (int c = 0; c < EA; ++c) { const float v = bf2f(vT[(size_t)c * T_ALL + tok]); a += v; q += v * v; }
        for (int k = 0; k < 16; ++k) *(float2*)(vstat + ((size_t)tok * 16 + k) * 2) = k == 0 ? make_float2(a, q) : make_float2(0.f, 0.f); }
}
__device__ __forceinline__ void p2_naive(const Params& p, int j) {
    const long long gt = (long long)bidx() * blockDim.x + tidx(), nth = (long long)gridDim.x * blockDim.x;
    const bf16_t* vT = (const bf16_t*)(p.ws + OFF_VT); bf16_t* uz = (bf16_t*)(p.ws + OFF_UZ); const float* vstat = (const float*)(p.ws + OFF_VSTAT);
    const float* lg = p.in[7] + (size_t)j * EA; const float* lb = p.in[8] + (size_t)j * EA;
    for (long long it = gt; it < (long long)T_ALL * 256; it += nth) {
        const int row = (int)(it % T_ALL), c0 = (int)(it / T_ALL) * 8, h = c0 >> 8; int base, t;
        if (row < T_PR) { base = row & ~127; t = row & 127; } else { const int r = row - T_PR; base = T_PR + (r & ~3); t = r & 3; }
        float acc[8], gg[8], bb[8];
#pragma unroll
        for (int i = 0; i < 8; ++i) { acc[i] = 0.f; gg[i] = lg[c0 + i]; bb[i] = lb[c0 + i]; }
        for (int s = 0; s <= t; ++s) {
            const float w = p.in[9][(((size_t)j * 8 + h) * 128 + t) * 128 + s];
            float mu, rstd; load_mu_rstd(vstat, base + s, mu, rstd);
#pragma unroll
            for (int i = 0; i < 8; ++i) { const float vl = (bf2f(vT[(size_t)(c0 + i) * T_ALL + base + s]) - mu) * rstd * gg[i] + bb[i]; acc[i] += w * vl;
                if (s == t && row >= T_PR) p.out[OUT_CV + ((size_t)j * 512 + (row - T_PR)) * EA + c0 + i] = vl; }
        }
        const float bs = p.in[10][((size_t)j * 8 + h) * 128 + t];
        float u[8], o[8]; bf16_t* up = uz + (size_t)row * EA + c0; unpk8(*(const u32x4*)up, u);
#pragma unroll
        for (int i = 0; i < 8; ++i) o[i] = u[i] * (acc[i] + bs);
        *(u32x4*)up = pk8(o);
    }
}

__device__ __forceinline__ void p2_fast(const Params& p, int j, LAS unsigned char* lds) {
    const int tid = tidx(), wid = tid >> 6, lane = tid & 63, fr = lane & 15, fq = lane >> 4;
    const bf16_t* vT = (const bf16_t*)(p.ws + OFF_VT); bf16_t* uz = (bf16_t*)(p.ws + OFF_UZ); const float* vstat = (const float*)(p.ws + OFF_VSTAT);
    const bf16_t* wsb = (const bf16_t*)(p.ws + OFF_WSB) + (size_t)j * 8 * 128 * 128; const float* rsum = (const float*)(p.ws + OFF_RS) + (size_t)j * 8 * 128;
    const float* lg = p.in[7] + (size_t)j * EA; const float* lb = p.in[8] + (size_t)j * EA; const float* bsp = p.in[10] + (size_t)j * 8 * 128;
    constexpr int PITCH = 272;
    LAS unsigned char* LA = lds; LAS unsigned char* LB = lds + 256 * PITCH;
    LAS float* Lmu = (LAS float*)(lds + 384 * PITCH); LAS float* Lrs = Lmu + 128; LAS float* Lm = Lmu + 256;
    u32x4 vreg[8]; float nmu = 0.f, nrs = 0.f;
    { const int u0 = bidx();
      if (u0 < 1024) { const int chunk = u0 >> 3, h = u0 & 7, tok0 = chunk * 128;
#pragma unroll
        for (int i = 0; i < 8; ++i) { const int idx = tid + 512 * i, row = idx >> 4, c16 = idx & 15; vreg[i] = *(const u32x4*)(vT + (size_t)(h * 256 + row) * T_ALL + tok0 + c16 * 8); }
        if (tid < 128) load_mu_rstd(vstat, tok0 + tid, nmu, nrs); } }
    for (int u = bidx(); u < 1024 + 128; u += gridDim.x) {
        if (u < 1024) {
            const int chunk = u >> 3, h = u & 7, tok0 = chunk * 128;
            if (tid < 128) { Lmu[tid] = nmu; Lrs[tid] = nrs; }
#pragma unroll
            for (int i = 0; i < 8; ++i) { const int idx = tid + 512 * i, row = idx >> 4, c16 = idx & 15; *(LAS u32x4*)(LA + row * PITCH + c16 * 16) = vreg[i]; }
            u32x4 ureg[8], wreg[4];
#pragma unroll
            for (int i = 0; i < 8; ++i) { const int idx = tid + 512 * i, t = idx >> 5, c16 = idx & 31; ureg[i] = *(const u32x4*)(uz + (size_t)(tok0 + t) * EA + h * 256 + c16 * 8); }
#pragma unroll
            for (int i = 0; i < 4; ++i) { const int idx = tid + 512 * i, t = idx >> 4, s0 = (idx & 15) * 8; wreg[i] = *(const u32x4*)(wsb + ((size_t)h * 128 + t) * 128 + s0); }
            __syncthreads();
            { const int un = u + gridDim.x;
              if (un < 1024) { const int chunk2 = un >> 3, h2 = un & 7, tok2 = chunk2 * 128;
#pragma unroll
                for (int i = 0; i < 8; ++i) { const int idx = tid + 512 * i, row = idx >> 4, c16 = idx & 15; vreg[i] = *(const u32x4*)(vT + (size_t)(h2 * 256 + row) * T_ALL + tok2 + c16 * 8); }
                if (tid < 128) load_mu_rstd(vstat, tok2 + tid, nmu, nrs); } }
#pragma unroll
            for (int i = 0; i < 4; ++i) { const int idx = tid + 512 * i, t = idx >> 4, s0 = (idx & 15) * 8;
                float f[8], g8[8]; unpk8(wreg[i], f);
#pragma unroll
                for (int k = 0; k < 8; ++k) f[k] *= Lrs[s0 + k];
                const u32x4 o = pk8(f); unpk8(o, g8); float part = 0.f;
#pragma unroll
                for (int k = 0; k < 8; ++k) part += g8[k] * Lmu[s0 + k];
                *(LAS u32x4*)(LB + t * PITCH + s0 * 2) = o;
                part = red16(part); if ((idx & 15) == 0) Lm[t] = part; }
            __syncthreads();
            f32x4 acc[2][8];
#pragma unroll
            for (int a = 0; a < 2; ++a)
#pragma unroll
                for (int n = 0; n < 8; ++n) acc[a][n] = (f32x4){0.f, 0.f, 0.f, 0.f};
#pragma unroll
            for (int ks = 0; ks < 4; ++ks) {
                const bf16x8 a0 = *(const LAS bf16x8*)(LA + (32 * wid + fr) * PITCH + (ks * 32 + fq * 8) * 2), a1 = *(const LAS bf16x8*)(LA + (32 * wid + 16 + fr) * PITCH + (ks * 32 + fq * 8) * 2);
#pragma unroll
                for (int nf = 0; nf < 8; ++nf) if (ks <= (nf >> 1)) {
                    const bf16x8 bb = *(const LAS bf16x8*)(LB + (16 * nf + fr) * PITCH + (ks * 32 + fq * 8) * 2);
                    acc[0][nf] = __builtin_amdgcn_mfma_f32_16x16x32_bf16(a0, bb, acc[0][nf], 0, 0, 0);
                    acc[1][nf] = __builtin_amdgcn_mfma_f32_16x16x32_bf16(a1, bb, acc[1][nf], 0, 0, 0); }
            }
            __syncthreads();
#pragma unroll
            for (int nf = 0; nf < 8; ++nf) { const int t = 16 * nf + fr; const float mt = Lm[t], rt = rsum[h * 128 + t], bst = bsp[h * 128 + t];
#pragma unroll
                for (int mf = 0; mf < 2; ++mf) { const int cl = 32 * wid + 16 * mf + 4 * fq, C = h * 256 + cl;
                    const f32x4 g4 = *(const f32x4*)(lg + C), b4 = *(const f32x4*)(lb + C); const f32x4 a = acc[mf][nf];
                    u32x2 o; o.x = pk2(g4[0] * (a[0] - mt) + b4[0] * rt + bst, g4[1] * (a[1] - mt) + b4[1] * rt + bst);
                    o.y = pk2(g4[2] * (a[2] - mt) + b4[2] * rt + bst, g4[3] * (a[3] - mt) + b4[3] * rt + bst);
                    *(LAS u32x2*)(LA + t * 528 + cl * 2) = o; } }
            __syncthreads();
#pragma unroll
            for (int i = 0; i < 8; ++i) { const int idx = tidx() + 512 * i, t = idx >> 5, c16 = idx & 31;
                float uu[8], gg[8]; unpk8(ureg[i], uu); unpk8(*(const LAS u32x4*)(LA + t * 528 + c16 * 16), gg);
#pragma unroll
                for (int k = 0; k < 8; ++k) uu[k] *= gg[k];
                *(u32x4*)(uz + (size_t)(tok0 + t) * EA + h * 256 + c16 * 8) = pk8(uu); }
            __syncthreads();
        } else {
            const int b = u - 1024, tokb = T_PR + 4 * b, c0 = tid * 4, h = c0 >> 8;
            float mu[4], rs[4], vl[4][4];
#pragma unroll
            for (int s2 = 0; s2 < 4; ++s2) load_mu_rstd(vstat, tokb + s2, mu[s2], rs[s2]);
            const f32x4 g4 = *(const f32x4*)(lg + c0), b4 = *(const f32x4*)(lb + c0);
#pragma unroll
            for (int cc = 0; cc < 4; ++cc) { const u32x2 w = *(const u32x2*)(vT + (size_t)(c0 + cc) * T_ALL + tokb);
                const float v[4] = {bflo(w.x), bfhi(w.x), bflo(w.y), bfhi(w.y)};
#pragma unroll
                for (int s2 = 0; s2 < 4; ++s2) vl[s2][cc] = (v[s2] - mu[s2]) * rs[s2] * g4[cc] + b4[cc]; }
#pragma unroll
            for (int s2 = 0; s2 < 4; ++s2) *(f32x4*)(p.out + OUT_CV + ((size_t)j * 512 + 4 * b + s2) * EA + c0) = (f32x4){vl[s2][0], vl[s2][1], vl[s2][2], vl[s2][3]};
#pragma unroll
            for (int t = 0; t < 4; ++t) { float sv[4]; const float bst = bsp[h * 128 + t];
#pragma unroll
                for (int cc = 0; cc < 4; ++cc) sv[cc] = bst;
#pragma unroll
                for (int s2 = 0; s2 <= t; ++s2) { const float w = p.in[9][(((size_t)j * 8 + h) * 128 + t) * 128 + s2];
#pragma unroll
                    for (int cc = 0; cc < 4; ++cc) sv[cc] += w * vl[s2][cc]; }
                bf16_t* up = uz + (size_t)(tokb + t) * EA + c0; const u32x2 w = *(const u32x2*)up;
                u32x2 o; o.x = pk2(bflo(w.x) * sv[0], bfhi(w.x) * sv[1]); o.y = pk2(bflo(w.y) * sv[2], bfhi(w.y) * sv[3]); *(u32x2*)up = o; }
        }
    }
}

__global__ void __launch_bounds__(512) mega(Params p) {
    extern __shared__ __attribute__((aligned(16))) unsigned char smem[];
    LAS unsigned char* lds = (LAS unsigned char*)smem;
    if (p.ws == nullptr) cg::this_grid().sync();
    volatile LAS unsigned* xbst = (volatile LAS unsigned*)(lds + STAGE_BYTES);
    if (tidx() == 0) { xbst[0] = 0u; xbst[1] = 0u; xbst[2] = 0u; xbst[3] = 0u; }
    __syncthreads();
    const XcdBarrier xb = xcd_barrier_post((unsigned*)(p.ws + OFF_BAR), xbst);
#define GRID_SYNC() xcd_barrier(xb)
    float* lt = (float*)smem;
    unsigned char* ws = p.ws;
    bf16_t* hn = (bf16_t*)(ws + OFF_HN); float* osq = (float*)(ws + OFF_OSQ); float* vstat = (float*)(ws + OFF_VSTAT);
    {
        if (bidx() & 1) { ssm_ktab(p, lt, 0, 512, 0); convert_weights(p, lt, 0, 1536, 0); } else { convert_weights(p, lt, 0, 1536, 0); ssm_ktab(p, lt, 0, 512, 0); }
        ssm_tables(p);
        ws_prep(p);
        rownorm_phase(p, true, true, nullptr, nullptr, nullptr, nullptr, p.in[4], true);
    }
    GRID_SYNC();
#pragma unroll 1
    for (int j = 0; j < 2; ++j) {
        const int la = 2 * j, lb_ = 2 * j + 1;
        { GemmD g{hn, (const bf16_t*)(ws + OFF_WINA) + (size_t)j * 6144 * 1024, 1024, 1024, 66, 16, 1, 1024, 0, 0};
          EpiUZ e{(bf16_t*)(ws + OFF_UZ)};
          GemmD g2{(const bf16_t*)(ws + OFF_WINA) + (size_t)j * 6144 * 1024 + (size_t)4096 * 1024, hn, 1024, 1024, 8, 66, 1, 1024, 0, 0};
          EpiVT e2; e2.vT = (bf16_t*)(ws + OFF_VT); e2.vstat = vstat;
#if FAST_GEMM
          gemm_fast<EpiUZ, EpiVT, true>(lds, g, e, g2, e2);
          if (j == 0) convert_weights(p, lt, 1536, 3328, 48);
#else
          run_gemm<0>(lds, g, e); run_gemm<1>(lds, g2, e2);
#endif
        }
        GRID_SYNC();
#if !FAST_GEMM
        vstat_naive(p); GRID_SYNC();
#endif
#if FAST_P2
        p2_fast(p, j, lds);
#else
        p2_naive(p, j);
#endif
        GRID_SYNC();
        { GemmD g{(const bf16_t*)(ws + OFF_UZ), (const bf16_t*)(ws + OFF_WOUTA) + (size_t)j * 1024 * 2048, 2048, 2048, 64, 4, 1, 2048, 0, 0};
          EpiOut e{(bf16_t*)(ws + OFF_ORA), osq}; run_gemm<2>(lds, g, e);
          GemmD g2{(const bf16_t*)(ws + OFF_UZ) + (size_t)T_PR * 2048, (const bf16_t*)(ws + OFF_WOUTA) + (size_t)j * 1024 * 2048, 2048, 2048, 2, 4, 4, 512, 512, 512};
          EpiPart e2{(float*)(ws + OFF_S)}; run_gemm<2>(lds, g2, e2);
          if (j == 0) ssm_ktab(p, lt, 512, 1024, 32); }
        GRID_SYNC();
        rownorm_phase(p, false, j == 0, (const bf16_t*)(ws + OFF_ORA), osq, (const float*)(ws + OFF_S), p.in[5] + (size_t)la * D, p.in[4] + (size_t)lb_ * D, true);
        GRID_SYNC();
        { GemmD g{hn, (const bf16_t*)(ws + OFF_WINB) + (size_t)j * 2048 * 1024, 1024, 1024, 66, 8, 1, 1024, 0, 0};
          EpiInB e{(bf16_t*)(ws + OFF_XH), (bf16_t*)(ws + OFF_SZ), (bf16_t*)(ws + OFF_XBS)}; run_gemm<3>(lds, g, e);
          ssm_build(p, j, 16); }
        GRID_SYNC();
        { GemmD g{(const bf16_t*)(ws + OFF_XH), (const bf16_t*)(ws + OFF_WG), XHW, 512, 2, 1, 64, 512, (long long)NCHK * XHW, 128LL * 512};
          EpiS1 e{(float*)(ws + OFF_S)}; run_gemm<4>(lds, g, e);
          ssm_mid(p, j, lds); }
        GRID_SYNC();
        { GemmD g{(const bf16_t*)(ws + OFF_XH), (const bf16_t*)(ws + OFF_TV), XHW, 640, 2, 2, 64, 640, (long long)NCHK * XHW, 512LL * 640, 1};
          EpiS3 e{hn}; run_gemm<5>(lds, g, e); }
        GRID_SYNC();
        { GemmD g{hn, (const bf16_t*)(ws + OFF_WGLU) + (size_t)j * 2048 * 1024, 1024, 1024, 66, 8, 1, 1024, 0, 0};
          EpiGlu e{(bf16_t*)(ws + OFF_SZ), p.in[22] + (size_t)j * D, p.in[24] + (size_t)j * D}; run_gemm<6>(lds, g, e);
          if (j == 0) { convert_weights(p, lt, 3328, 3328 + 1536, 16); convert_weights(p, lt, 3328 + 2048, 6656, 16); } }
        GRID_SYNC();
        { GemmD g{(const bf16_t*)(ws + OFF_SZ), (const bf16_t*)(ws + OFF_WOUTB) + (size_t)j * 1024 * 1024, 1024, 1024, 64, 4, 1, 1024, 0, 0};
          EpiOut e{(bf16_t*)(ws + OFF_ORB), osq}; run_gemm<7>(lds, g, e);
          GemmD g2{(const bf16_t*)(ws + OFF_SZ) + (size_t)T_PR * 1024, (const bf16_t*)(ws + OFF_WOUTB) + (size_t)j * 1024 * 1024, 1024, 1024, 2, 4, 4, 256, 256, 256};
          EpiPart e2{(float*)(ws + OFF_S)}; run_gemm<7>(lds, g2, e2);
          if (j == 0) convert_weights(p, lt, 3328 + 1536, 3328 + 2048, 32); }
        GRID_SYNC();
        rownorm_phase(p, false, false, (const bf16_t*)(ws + OFF_ORB), osq, (const float*)(ws + OFF_S), p.in[5] + (size_t)lb_ * D, p.in[4] + (size_t)(lb_ + 1 < 4 ? lb_ + 1 : 0) * D, j == 0);
        if (j == 0) GRID_SYNC();
    }
}

extern "C" void kernel_launch(void* const* d_in, const int* in_sizes, int n_in, void* d_out, int out_size, void* d_ws, size_t ws_size, hipStream_t stream) {
    static int grid_blocks = 0;
    constexpr size_t kDynLds = STAGE_BYTES + 64;
    if (!grid_blocks) {
        int dev = 0, cus = 0, per_cu = 0;
        (void)hipGetDevice(&dev);
        (void)hipDeviceGetAttribute(&cus, hipDeviceAttributeMultiprocessorCount, dev);
        (void)hipFuncSetAttribute((const void*)mega, hipFuncAttributeMaxDynamicSharedMemorySize, (int)kDynLds);
        (void)hipOccupancyMaxActiveBlocksPerMultiprocessor(&per_cu, mega, 512, kDynLds);
        if (per_cu < 1) { fprintf(stderr, "occupancy query says %d blocks/CU\n", per_cu); per_cu = 1; }
        grid_blocks = cus;
        if (n_in != 26 || ws_size < 254 * MiB) fprintf(stderr, "unexpected n_in %d / ws_size %zu\n", n_in, ws_size);
    }
    Params p{};
    for (int i = 0; i < 26; ++i) p.in[i] = (const float*)d_in[i];
    p.out = (float*)d_out; p.ws = (unsigned char*)d_ws;
    (void)hipMemsetAsync((unsigned char*)d_ws + OFF_BAR, 0, XCD_BAR_WORDS * sizeof(unsigned), stream);
    void* args[] = {&p};
    hipError_t e = hipLaunchCooperativeKernel((void*)mega, dim3(grid_blocks), dim3(512), args, kDynLds, stream);
    if (e != hipSuccess) fprintf(stderr, "cooperative launch failed: %s (grid %d)\n", hipGetErrorString(e), grid_blocks);
}
```
